# Optimizing an MI355X kernel written in HIP

```python
import math
import jax, jax.numpy as jnp
from jax import lax
import numpy as np

D_MODEL = 1024
BATCH = 16
SEQ = 2048
DEPTH = 4

N_A_LAYERS = DEPTH // 2
N_B_LAYERS = DEPTH - N_A_LAYERS
SSM_GROUP = 16
SSM_GROUPS = D_MODEL // SSM_GROUP
SSM_STATE = 64
DT_MIN = 1e-3
DT_MAX = 1e-1
HEAD_DIM = 64
N_HEADS = D_MODEL // HEAD_DIM
DILATED_BRANCHES = ((128, 1), (512, 4), (2048, 16))
N_BRANCHES = len(DILATED_BRANCHES)
BRANCH_WIDTH = N_HEADS * HEAD_DIM
Q_WIDTH = N_BRANCHES * BRANCH_WIDTH
D_FF = 4 * D_MODEL
BLOCK = 128
EPS = 1e-6
NEG = -1e30

kernel_name = "yoco_s5_dilated_attn_hybrid"


def rms_norm(x, g):
    xf = x.astype(jnp.float32)
    y = xf * lax.rsqrt(jnp.mean(xf * xf, axis=-1, keepdims=True) + EPS)
    return (y * g.astype(jnp.float32)).astype(x.dtype)


def ada_chunks(c, w, b, n):
    m = jax.nn.silu(c) @ w + b
    return jnp.split(m[:, None, :], n, axis=-1)


def s5_mixer(u, lam_re, lam_im, log_dt, b_re, b_im, c_re, c_im, d_skip, w_glu):
    bsz, seq, dm = u.shape
    f32 = jnp.float32
    lam = lax.complex(lam_re.astype(f32), lam_im.astype(f32))
    dt = jnp.exp(log_dt.astype(f32))[:, None]
    lam_bar = jnp.exp(lam * dt)
    b_mat = lax.complex(b_re.astype(f32), b_im.astype(f32))
    b_bar = ((lam_bar - 1.0) / lam)[..., None] * b_mat
    c_mat = lax.complex(c_re.astype(f32), c_im.astype(f32))
    uf = u.astype(f32)
    ug = uf.reshape(bsz, seq, SSM_GROUPS, SSM_GROUP).astype(jnp.complex64)
    bu = jnp.einsum('bsgc,gpc->bsgp', ug, b_bar)
    a = jnp.broadcast_to(lam_bar, (1, seq) + lam_bar.shape)

    def combine(left, right):
        a_l, b_l = left
        a_r, b_r = right
        return a_r * a_l, a_r * b_l + b_r

    _, state = lax.associative_scan(combine, (a, bu), axis=1)
    y = jnp.einsum('bsgp,gcp->bsgc', state, c_mat).real.reshape(bsz, seq, dm)
    y = y + d_skip.astype(f32) * uf
    z = jax.nn.gelu(y).astype(u.dtype)
    val, gate = jnp.split(z @ w_glu, 2, axis=-1)
    return val * jax.nn.sigmoid(gate)


def to_dilated_blocks(t, dil):
    bsz, seq = t.shape[:2]
    rest = t.shape[2:]
    sub = seq // dil
    nb = -(-sub // BLOCK)
    t = jnp.swapaxes(t.reshape((bsz, sub, dil) + rest), 1, 2)
    t = jnp.pad(t, [(0, 0), (0, 0), (0, nb * BLOCK - sub)] + [(0, 0)] * len(rest))
    return t.reshape((bsz, dil, nb, BLOCK) + rest)


def from_dilated_blocks(t, seq):
    bsz, dil, nb, blk = t.shape[:4]
    rest = t.shape[4:]
    sub = seq // dil
    t = t.reshape((bsz, dil, nb * blk) + rest)[:, :, :sub]
    return jnp.swapaxes(t, 1, 2).reshape((bsz, seq) + rest)


def band_keys(t):
    prev = jnp.concatenate([jnp.zeros_like(t[:, :, :1]), t[:, :, :-1]], axis=2)
    return jnp.concatenate([prev, t], axis=3)


def band_mask(nb, span):
    qi = jnp.arange(BLOCK)[:, None]
    kj = jnp.arange(2 * BLOCK)[None, :] - BLOCK
    dist = qi - kj
    rel = (dist >= 0) & (dist <= span)
    abs_k = jnp.arange(nb)[:, None, None] * BLOCK + kj[None]
    return rel[None] & (abs_k >= 0)


def dilated_branch(q, k_band, v_band, span, dil):
    f32 = jnp.float32
    seq = q.shape[1]
    qb = to_dilated_blocks(q, dil).astype(f32)
    nb = qb.shape[2]
    s = jnp.einsum('brnqhe,brnkhe->brnhqk', qb, k_band.astype(f32)) * (HEAD_DIM ** -0.5)
    s = jnp.where(band_mask(nb, span)[None, None, :, None], s, NEG)
    m = jnp.max(s, axis=-1, keepdims=True)
    p = jnp.exp(s - m)
    den = jnp.sum(p, axis=-1)
    o = jnp.einsum('brnhqk,brnkhe->brnqhe', p, v_band.astype(f32))
    o = o / jnp.swapaxes(den, 3, 4)[..., None]
    lse = jnp.swapaxes(m[..., 0] + jnp.log(den), 3, 4)
    return from_dilated_blocks(o, seq), from_dilated_blocks(lse, seq)


def shared_kv(h, c, kv_g, kv_ada_w, kv_ada_b, w_kv):
    bsz, seq, _ = h.shape
    shift, scale = ada_chunks(c, kv_ada_w, kv_ada_b, 2)
    u = rms_norm(h, kv_g) * (1.0 + scale) + shift
    kv = (u @ w_kv).reshape(bsz, seq, 2, N_BRANCHES, N_HEADS, HEAD_DIM)
    k_bands, v_bands = [], []
    for i, (win, dil) in enumerate(DILATED_BRANCHES):
        k_bands.append(band_keys(to_dilated_blocks(kv[:, :, 0, i], dil)))
        v_bands.append(band_keys(to_dilated_blocks(kv[:, :, 1, i], dil)))
    return k_bands, v_bands


def dilated_mixer(u, w_q, k_bands, v_bands, w_o):
    bsz, seq, _ = u.shape
    q = (u @ w_q).reshape(bsz, seq, N_BRANCHES, N_HEADS, HEAD_DIM)
    outs, lses = [], []
    for i, (win, dil) in enumerate(DILATED_BRANCHES):
        o, l = dilated_branch(q[:, :, i], k_bands[i], v_bands[i], win // dil, dil)
        outs.append(o)
        lses.append(l)
    weights = jax.nn.softmax(jnp.stack(lses, axis=-1), axis=-1)
    o = jnp.einsum('gbshe,bshg->bshe', jnp.stack(outs), weights)
    return o.reshape(bsz, seq, BRANCH_WIDTH).astype(u.dtype) @ w_o


def setup_inputs(seed: int = 0) -> dict:
    key = jax.random.key(seed)
    ks = jax.random.split(key, 24)
    f32 = jnp.float32

    def nrm(k, shape, std):
        return jax.random.normal(k, shape, f32) * std

    n_idx = jnp.arange(SSM_STATE, dtype=f32)
    gp = (N_A_LAYERS, SSM_GROUPS, SSM_STATE)
    return {
        "x": nrm(ks[0], (BATCH, SEQ, D_MODEL), 1.0),
        "c": nrm(ks[1], (BATCH, D_MODEL), 1.0),
        "ln_g": 1.0 + nrm(ks[2], (DEPTH, 2, D_MODEL), 0.02),
        "ada_w": nrm(ks[3], (DEPTH, 2, D_MODEL, 3 * D_MODEL), 0.5 * D_MODEL ** -0.5),
        "ada_b": nrm(ks[4], (DEPTH, 2, 3 * D_MODEL), 0.02),
        "ssm_lam_re": -0.5 + nrm(ks[5], gp, 0.01),
        "ssm_lam_im": math.pi * n_idx + nrm(ks[6], gp, 0.01),
        "ssm_log_dt": jax.random.uniform(ks[7], (N_A_LAYERS, SSM_GROUPS), f32, math.log(DT_MIN), math.log(DT_MAX)),
        "ssm_b_re": nrm(ks[8], gp + (SSM_GROUP,), (2 * SSM_GROUP) ** -0.5),
        "ssm_b_im": nrm(ks[9], gp + (SSM_GROUP,), (2 * SSM_GROUP) ** -0.5),
        "ssm_c_re": nrm(ks[10], (N_A_LAYERS, SSM_GROUPS, SSM_GROUP, SSM_STATE), 0.5),
        "ssm_c_im": nrm(ks[11], (N_A_LAYERS, SSM_GROUPS, SSM_GROUP, SSM_STATE), 0.5),
        "ssm_d": nrm(ks[12], (N_A_LAYERS, D_MODEL), 1.0),
        "ssm_w_glu": nrm(ks[13], (N_A_LAYERS, D_MODEL, 2 * D_MODEL), D_MODEL ** -0.5),
        "kv_g": 1.0 + nrm(ks[14], (D_MODEL,), 0.02),
        "kv_ada_w": nrm(ks[15], (D_MODEL, 2 * D_MODEL), 0.5 * D_MODEL ** -0.5),
        "kv_ada_b": nrm(ks[16], (2 * D_MODEL,), 0.02),
        "w_kv": nrm(ks[17], (D_MODEL, 2 * Q_WIDTH), D_MODEL ** -0.5),
        "attn_w_q": nrm(ks[18], (N_B_LAYERS, D_MODEL, Q_WIDTH), D_MODEL ** -0.5),
        "attn_w_o": nrm(ks[19], (N_B_LAYERS, BRANCH_WIDTH, D_MODEL), BRANCH_WIDTH ** -0.5),
        "mlp_w1": nrm(ks[20], (DEPTH, D_MODEL, D_FF), D_MODEL ** -0.5),
        "mlp_w2": nrm(ks[21], (DEPTH, D_FF, D_MODEL), D_FF ** -0.5),
        "final_g": 1.0 + nrm(ks[22], (D_MODEL,), 0.02),
    }


def reference(x, c, ln_g, ada_w, ada_b, ssm_lam_re, ssm_lam_im, ssm_log_dt, ssm_b_re, ssm_b_im,
              ssm_c_re, ssm_c_im, ssm_d, ssm_w_glu, kv_g, kv_ada_w, kv_ada_b, w_kv,
              attn_w_q, attn_w_o, mlp_w1, mlp_w2, final_g):
    h = x
    k_bands, v_bands = None, None
    for layer in range(DEPTH):
        if layer == N_A_LAYERS:
            k_bands, v_bands = shared_kv(h, c, kv_g, kv_ada_w, kv_ada_b, w_kv)
        shift, scale, gate = ada_chunks(c, ada_w[layer, 0], ada_b[layer, 0], 3)
        u = rms_norm(h, ln_g[layer, 0]) * (1.0 + scale) + shift
        if layer < N_A_LAYERS:
            y = s5_mixer(u, ssm_lam_re[layer], ssm_lam_im[layer], ssm_log_dt[layer], ssm_b_re[layer],
                         ssm_b_im[layer], ssm_c_re[layer], ssm_c_im[layer], ssm_d[layer], ssm_w_glu[layer])
        else:
            j = layer - N_A_LAYERS
            y = dilated_mixer(u, attn_w_q[j], k_bands, v_bands, attn_w_o[j])
        h = h + gate * y
        shift, scale, gate = ada_chunks(c, ada_w[layer, 1], ada_b[layer, 1], 3)
        u = rms_norm(h, ln_g[layer, 1]) * (1.0 + scale) + shift
        h = h + gate * (jnp.square(jax.nn.relu(u @ mlp_w1[layer])) @ mlp_w2[layer])
    return rms_norm(h, final_g)
```

```cpp
#include <hip/hip_runtime.h>
#include <hip/hip_cooperative_groups.h>
#include <cstdio>
#include <cstdint>
namespace cg = cooperative_groups;

#ifndef ONE_LAUNCH
#define ONE_LAUNCH 1
#endif

#define LAS __attribute__((address_space(3)))
typedef unsigned short bf16_t;
typedef short bf16x8 __attribute__((ext_vector_type(8)));
typedef short s16x4 __attribute__((ext_vector_type(4)));
typedef float f32x4 __attribute__((ext_vector_type(4)));
typedef float f32x2 __attribute__((ext_vector_type(2)));
typedef float f32x16 __attribute__((ext_vector_type(16)));
typedef unsigned u32x4 __attribute__((ext_vector_type(4)));
typedef unsigned u32x2 __attribute__((ext_vector_type(2)));
typedef __bf16 bf16x2_t __attribute__((ext_vector_type(2)));

constexpr int DM = 1024, SEQ = 2048, NB = 16, MTOK = NB * SEQ, FF = 4096, QW = 3072, KVW = 6144;
constexpr int MH = MTOK / 2;
constexpr float EPS = 1e-6f;
constexpr float C2 = 0.125f * 1.4426950408889634f;
constexpr int SSQ_LD = 32;

constexpr size_t MiB = 1u << 20;
constexpr size_t WS_MODS = 1 * MiB;
constexpr size_t WS_KVMODS = WS_MODS + 8 * 16 * 3072 * 4;
constexpr size_t WS_GM = 3 * MiB;
constexpr size_t WS_SW1 = 4 * MiB;
constexpr size_t WS_SWQ = 5 * MiB;
constexpr size_t WS_SWKV = 5 * MiB + 512 * 1024;
constexpr size_t WS_LAMB = 6 * MiB;
constexpr size_t WS_BM = 6 * MiB + 64 * 1024;
constexpr size_t WS_CM = 6 * MiB + 64 * 1024 + 512 * 1024;
constexpr size_t WS_LSE = 8 * MiB;
constexpr size_t WS_SSQ = 12 * MiB;
constexpr size_t WS_WKV = 16 * MiB;
constexpr size_t WS_WQ = 28 * MiB;
constexpr size_t WS_WO = 40 * MiB;
constexpr size_t WS_W1B = 44 * MiB;
constexpr size_t WS_W2B = 60 * MiB;
constexpr size_t WS_WGLU = 76 * MiB;
constexpr size_t WS_W1A = 84 * MiB;
constexpr size_t WS_W2A = 100 * MiB;
constexpr size_t WS_HSKV0 = 180 * MiB;
constexpr size_t WS_HSKV1 = 76 * MiB;
constexpr size_t WS_HS = 116 * MiB;
constexpr size_t WS_R = 180 * MiB;
constexpr size_t WS_Q = WS_R + 32 * MiB;
constexpr size_t WS_O = WS_R;
constexpr size_t WS_ACTH = WS_R;
constexpr size_t WS_KVH = WS_R + 128 * MiB;
constexpr size_t WS_Z = WS_R;
constexpr size_t WS_ACTF = WS_R + 64 * MiB;
constexpr size_t WS_NEED = 500 * MiB;

constexpr int LDS_BYTES = 163840;

__device__ __forceinline__ unsigned f2bf(float f) { unsigned u = __builtin_bit_cast(unsigned, f); return (u + 0x7fffu + ((u >> 16) & 1u)) >> 16; }
__device__ __forceinline__ unsigned pk2(float lo, float hi) { f32x2 v = {lo, hi}; bf16x2_t b = __builtin_convertvector(v, bf16x2_t); return __builtin_bit_cast(unsigned, b); }
__device__ __forceinline__ float bf2f(unsigned short b) { return __builtin_bit_cast(float, (unsigned)b << 16); }
__device__ __forceinline__ float bflo(unsigned w) { return __builtin_bit_cast(float, w << 16); }
__device__ __forceinline__ float bfhi(unsigned w) { return __builtin_bit_cast(float, w & 0xffff0000u); }
__device__ __forceinline__ int crow(int r, int hi) { return (r & 3) + 8 * (r >> 2) + 4 * hi; }
template <class T> __device__ __forceinline__ T* opq(T* p) { size_t z = 0; asm volatile("" : "+s"(z)); return (T*)((char*)p + z); }
__device__ __forceinline__ int lane_id() { int l; asm volatile("v_mbcnt_lo_u32_b32 %0, -1, 0\n\tv_mbcnt_hi_u32_b32 %0, -1, %0" : "=v"(l)); return l; }
#define MFMA32(a, b, c) __builtin_amdgcn_mfma_f32_32x32x16_bf16((a), (b), (c), 0, 0, 0)
#define LDS_WAIT() asm volatile("s_waitcnt lgkmcnt(0)" ::: "memory")


__device__ __forceinline__ double exp_d(double x) {
    const double kf = __builtin_rint(x * 1.4426950408889634074);
    const double r = (x - kf * 0.693147180369123816490) - kf * 1.90821492927058770002e-10;
    double p = 1.0 / 6227020800.0;
    p = p * r + 1.0 / 479001600.0; p = p * r + 1.0 / 39916800.0; p = p * r + 1.0 / 3628800.0; p = p * r + 1.0 / 362880.0; p = p * r + 1.0 / 40320.0;
    p = p * r + 1.0 / 5040.0; p = p * r + 1.0 / 720.0; p = p * r + 1.0 / 120.0; p = p * r + 1.0 / 24.0; p = p * r + 1.0 / 6.0; p = p * r + 0.5; p = p * r + 1.0; p = p * r + 1.0;
    const long long bits = ((long long)((int)kf + 1023)) << 52;
    return p * __builtin_bit_cast(double, bits);
}
__device__ __forceinline__ void sincos_d(double x, double& sn, double& cs) {
    const double k = __builtin_rint(x * 0.15915494309189533577);
    double r = (x - k * 6.28318530717958623200) - k * 2.44929359829470635445e-16;
    const double t = r * 0.125, t2 = t * t;
    double s = -1.0 / 6227020800.0; s = s * t2 + 1.0 / 39916800.0; s = s * t2 - 1.0 / 362880.0; s = s * t2 + 1.0 / 5040.0; s = s * t2 - 1.0 / 120.0; s = s * t2 + 1.0 / 6.0; s = t - t * t2 * s;
    s = t * (1.0 + t2 * (-1.0 / 6.0 + t2 * (1.0 / 120.0 + t2 * (-1.0 / 5040.0 + t2 * (1.0 / 362880.0 + t2 * (-1.0 / 39916800.0 + t2 * (1.0 / 6227020800.0)))))));
    double c = 1.0 + t2 * (-0.5 + t2 * (1.0 / 24.0 + t2 * (-1.0 / 720.0 + t2 * (1.0 / 40320.0 + t2 * (-1.0 / 3628800.0 + t2 * (1.0 / 479001600.0 + t2 * (-1.0 / 87178291200.0)))))));
#pragma unroll
    for (int i = 0; i < 3; ++i) { const double s2 = 2.0 * s * c, c2 = 1.0 - 2.0 * s * s; s = s2; c = c2; }
    sn = s; cs = c;
}

namespace pg8 {
constexpr int BM = 256, BK = 64, HALF = 128, HTB = HALF * BK * 2, STAGE_BYTES = 8 * HTB, NXCD = 8, WGM = 4;
__host__ __device__ __forceinline__ int lds_byte(int r, int c) { const int st = (r >> 4) * 2 + (c >> 5), rr = r & 15, cc = c & 31, ob = rr * 64 + cc * 2; return st * 1024 + (ob ^ (((ob >> 9) & 1) << 5)); }
__host__ __device__ __forceinline__ void stage_rc(int b, int& R, int& C) { const int st = b / 1024, sb = b % 1024, swz = sb ^ (((sb >> 9) & 1) << 5); R = (st >> 1) * 16 + swz / 64; C = (st & 1) * 32 + (swz % 64) / 2; }
__host__ __device__ __forceinline__ int perm32(int rho) { const int n = rho >> 4, i = rho & 15; return 8 * (i >> 2) + 4 * n + (i & 3); }
struct Unit { int pm, pn; };
struct Gemm { const bf16_t* A; const bf16_t* Bt; int M, N, K; };
struct StaticOrder {
    int nM, nN, nwg, G, c;
    __host__ __device__ void init(int M, int N, int G_, int c_) { nM = M / BM; nN = N / BM; nwg = nM * nN; G = G_; c = c_; }
    __host__ __device__ bool next(int i, Unit& u) const {
        const long L = (long)i * G + c; if (L >= nwg) return false;
        int wgid = (int)L; { const int q = nwg / NXCD, r = nwg % NXCD, xcd = wgid % NXCD, off = wgid / NXCD; wgid = (xcd < r ? xcd * (q + 1) : r * (q + 1) + (xcd - r) * q) + off; }
        const int nig = WGM * nN, gid = wgid / nig, fm = gid * WGM, gsz = (nM - fm) < WGM ? (nM - fm) : WGM;
        u.pm = fm + ((wgid % nig) % gsz); u.pn = (wgid % nig) / gsz; return true;
    }
    __device__ __forceinline__ void a_ready(const Unit&) const {}
    __device__ __forceinline__ void done(const Unit&) const {}
};

__device__ __forceinline__ float row_rstd(const float* ssq, size_t grow, int nslots) {
    const f32x4* p = (const f32x4*)(ssq + grow * SSQ_LD);
    f32x4 a = p[0] + p[1] + p[2] + p[3];
    if (nslots > 16) a = a + p[4] + p[5] + p[6] + p[7];
    const float s = (a[0] + a[1]) + (a[2] + a[3]);
    return __builtin_amdgcn_rsqf(s * (1.0f / DM) + EPS);
}

__device__ __forceinline__ float row_rstd4(const float* ssq, size_t grow, int nslots, int fq) {
    const f32x4* p = (const f32x4*)(ssq + grow * SSQ_LD);
    f32x4 a = p[fq];
    if (nslots > 16) a = a + p[4 + fq];
    float s = (a[0] + a[1]) + (a[2] + a[3]);
    s += __shfl_xor(s, 16); s += __shfl_xor(s, 32);
    return __builtin_amdgcn_rsqf(s * (1.0f / DM) + EPS);
}
__device__ __forceinline__ int perm_pos(int br, int pos) { return br == 0 ? pos : (br == 1 ? ((pos & 3) * 512 + (pos >> 2)) : ((pos & 15) * 128 + (pos >> 4))); }
struct EpiAct {
    static constexpr bool PERM = true;
    bf16_t* O; int ldc; const float* ssq; int nslots; const float* sw; int row_off; int act; float scale; int hm;
    unsigned rl_addr;
    __device__ __forceinline__ void operator()(const f32x4 (&acc)[2][2][4][2], const Unit& u, int wr, int wc, int fr, int fq, int ui) const {
#ifdef NO_ACT
        if (row_off >= 0) return;
#endif
        bf16_t* const O = opq(this->O); const float* const ssq = opq(this->ssq); const float* const sw = opq(this->sw);
        const int row0 = u.pm * BM + wr * 64 + fr; const int b = (row_off + u.pm * BM) >> 11;
        const int col0 = u.pn * BM + wc * 32 + 8 * fq;
        f32x4 bv[2][2];
#pragma unroll
        for (int bj = 0; bj < 2; ++bj)
#pragma unroll
            for (int n = 0; n < 2; ++n) bv[bj][n] = *(const f32x4*)(sw + (size_t)b * ldc + col0 + bj * HALF + 4 * n);
#pragma unroll
        for (int ai = 0; ai < 2; ++ai)
#pragma unroll
            for (int m = 0; m < 4; ++m) {
                const int lrow = row0 + ai * HALF + m * 16;
                const float rs = *(const LAS float*)(unsigned long)(rl_addr + 4u * (unsigned)(ui * BM + (lrow - u.pm * BM)));
                bf16_t* rowp = O + (size_t)lrow * ldc + col0;
                if (hm) { const int br = ((u.pn * BM) >> 10) % 3; rowp = O + ((size_t)(col0 >> 6) * MH + (lrow & ~2047) + perm_pos(br, lrow & 2047)) * 64 + (col0 & 63); }
#pragma unroll
                for (int bj = 0; bj < 2; ++bj) {
                    f32x4 v0 = acc[ai][bj][m][0] * rs + bv[bj][0], v1 = acc[ai][bj][m][1] * rs + bv[bj][1];
                    if (act == 1) {
#pragma unroll
                        for (int j = 0; j < 4; ++j) { float x = fmaxf(v0[j], 0.f); v0[j] = x * x; float y = fmaxf(v1[j], 0.f); v1[j] = y * y; }
                    }
                    v0 = v0 * scale; v1 = v1 * scale;
                    u32x4 w; w.x = pk2(v0[0], v0[1]); w.y = pk2(v0[2], v0[3]); w.z = pk2(v1[0], v1[1]); w.w = pk2(v1[2], v1[3]);
                    *(u32x4*)(rowp + (hm ? bj * 2 * MH * 64 : bj * HALF)) = w;
                }
                asm volatile("" ::: "memory");
            }
    }
};

constexpr int HLD = 2048;
__device__ __forceinline__ f32x4 ld_h4(const bf16_t* p) { const u32x2 w = *(const u32x2*)p; return (f32x4){bflo(w.x), bfhi(w.x), bflo(w.y), bfhi(w.y)}; }
__device__ __forceinline__ void st_h4(bf16_t* p, const f32x4 v) { u32x2 w; w.x = pk2(v[0], v[1]); w.y = pk2(v[2], v[3]); *(u32x2*)p = w; }
__device__ __forceinline__ void ld_h8(const bf16_t* p, f32x4& a, f32x4& b) { const u32x4 w = *(const u32x4*)p; a = (f32x4){bflo(w.x), bfhi(w.x), bflo(w.y), bfhi(w.y)}; b = (f32x4){bflo(w.z), bfhi(w.z), bflo(w.w), bfhi(w.w)}; }
__device__ __forceinline__ void st_h8(bf16_t* p, const f32x4 a, const f32x4 b) { u32x4 w; w.x = pk2(a[0], a[1]); w.y = pk2(a[2], a[3]); w.z = pk2(b[0], b[1]); w.w = pk2(b[2], b[3]); *(u32x4*)p = w; }
struct EpiRes {
    static constexpr bool PERM = true;
    const bf16_t* res; bf16_t* hout; bf16_t* hs; const float* gate; const float* gm; float* ssq; int row_off;
    bf16_t* hs2a; bf16_t* hs2b; const float* gm2;
    __device__ __forceinline__ void operator()(const f32x4 (&acc)[2][2][4][2], const Unit& u, int wr, int wc, int fr, int fq, int ui) const {
#ifdef NO_RES
        if (row_off >= 0) return;
#endif
        const bf16_t* const res = opq(this->res); bf16_t* const hout = opq(this->hout); bf16_t* const hs = opq(this->hs); const float* const gate = opq(this->gate); const float* const gm = opq(this->gm); float* const ssq = opq(this->ssq);
        const int b = (row_off + u.pm * BM) >> 11;
        const int col0 = u.pn * BM + wc * 32 + 8 * fq;
        const float* gp = gate + (size_t)b * 3072 + col0; const float* mp = gm + (size_t)b * DM + col0;
        const bool two = gm2 != nullptr;
        const float* mp2 = two ? opq(gm2) + (size_t)b * DM + col0 : mp;
        bf16_t* h2 = (row_off + u.pm * BM >= MH) ? opq(hs2b) - (size_t)MH * DM : opq(hs2a);
        float ssv[2][4];
#pragma unroll
        for (int ai = 0; ai < 2; ++ai)
#pragma unroll
            for (int m = 0; m < 4; ++m) ssv[ai][m] = 0.f;
#pragma unroll
        for (int bj = 0; bj < 2; ++bj) {
            const int co = bj * HALF;
            const f32x4 gv0 = *(const f32x4*)(gp + co), gv1 = *(const f32x4*)(gp + co + 4), mv0 = *(const f32x4*)(mp + co), mv1 = *(const f32x4*)(mp + co + 4);
#pragma unroll
            for (int ai = 0; ai < 2; ++ai)
#pragma unroll
                for (int m = 0; m < 4; ++m) {
                    const size_t grow = (size_t)(row_off + u.pm * BM + ai * HALF + wr * 64 + m * 16 + fr);
                    f32x4 r0, r1; ld_h8(res + grow * HLD + col0 + co, r0, r1);
                    const f32x4 hn0 = r0 + gv0 * acc[ai][bj][m][0], hn1 = r1 + gv1 * acc[ai][bj][m][1];
                    st_h8(hout + grow * HLD + col0 + co, hn0, hn1);
                    ssv[ai][m] += ((hn0[0] * hn0[0] + hn0[1] * hn0[1]) + (hn0[2] * hn0[2] + hn0[3] * hn0[3])) + ((hn1[0] * hn1[0] + hn1[1] * hn1[1]) + (hn1[2] * hn1[2] + hn1[3] * hn1[3]));
                    st_h8(hs + grow * DM + col0 + co, hn0 * mv0, hn1 * mv1);
                    if (two) { const f32x4 m20 = *(const f32x4*)(mp2 + co), m21 = *(const f32x4*)(mp2 + co + 4); st_h8(h2 + grow * DM + col0 + co, hn0 * m20, hn1 * m21); }
                    asm volatile("" ::: "memory");
                }
        }
#pragma unroll
        for (int ai = 0; ai < 2; ++ai)
#pragma unroll
            for (int m = 0; m < 4; ++m) {
                const size_t grow = (size_t)(row_off + u.pm * BM + ai * HALF + wr * 64 + m * 16 + fr);
                float ss = ssv[ai][m];
                ss += __shfl_xor(ss, 16); ss += __shfl_xor(ss, 32);
                if (fq == 0) ssq[grow * SSQ_LD + u.pn * 4 + wc] = ss;
            }
    }
};

struct EpiGlu {
    static constexpr bool PERM = true;
    const void* res; int res_f32; bf16_t* hout; bf16_t* hs; const float* gate; const float* gm; float* ssq; int row_off;
    __device__ __forceinline__ void operator()(const f32x4 (&acc)[2][2][4][2], const Unit& u, int wr, int wc, int fr, int fq, int ui) const {
#ifdef NO_GLU
        if (row_off >= 0) return;
#endif
        const void* const res = opq(this->res); bf16_t* const hout = opq(this->hout); bf16_t* const hs = opq(this->hs); const float* const gate = opq(this->gate); const float* const gm = opq(this->gm); float* const ssq = opq(this->ssq);
        const int b = (row_off + u.pm * BM) >> 11;
        const int col0 = u.pn * HALF + wc * 32 + 8 * fq;
        const float* gp = gate + (size_t)b * 3072 + col0; const float* mp = gm + (size_t)b * DM + col0;
        const f32x4 gv0 = *(const f32x4*)(gp), gv1 = *(const f32x4*)(gp + 4), mv0 = *(const f32x4*)(mp), mv1 = *(const f32x4*)(mp + 4);
#pragma unroll
        for (int ai = 0; ai < 2; ++ai)
#pragma unroll
            for (int m = 0; m < 4; ++m) {
                const size_t grow = (size_t)(row_off + u.pm * BM + ai * HALF + wr * 64 + m * 16 + fr);
                f32x4 r0, r1;
                if (res_f32) { r0 = *(const f32x4*)((const float*)res + grow * DM + col0); r1 = *(const f32x4*)((const float*)res + grow * DM + col0 + 4); }
                else ld_h8((const bf16_t*)res + grow * HLD + col0, r0, r1);
                f32x4 hn0, hn1;
#pragma unroll
                for (int j = 0; j < 4; ++j) {
                    const float s0 = __builtin_amdgcn_rcpf(1.0f + __expf(-acc[ai][1][m][0][j])), s1 = __builtin_amdgcn_rcpf(1.0f + __expf(-acc[ai][1][m][1][j]));
                    hn0[j] = r0[j] + gv0[j] * (acc[ai][0][m][0][j] * s0); hn1[j] = r1[j] + gv1[j] * (acc[ai][0][m][1][j] * s1); }
                st_h8(hout + grow * HLD + col0, hn0, hn1);
                float ss = ((hn0[0] * hn0[0] + hn0[1] * hn0[1]) + (hn0[2] * hn0[2] + hn0[3] * hn0[3])) + ((hn1[0] * hn1[0] + hn1[1] * hn1[1]) + (hn1[2] * hn1[2] + hn1[3] * hn1[3]));
                st_h8(hs + grow * DM + col0, hn0 * mv0, hn1 * mv1);
                ss += __shfl_xor(ss, 16); ss += __shfl_xor(ss, 32);
                if (fq == 0) ssq[grow * SSQ_LD + u.pn * 4 + wc] = ss;
                asm volatile("" ::: "memory");
            }
    }
};

struct EpiFinal {
    static constexpr bool PERM = true;
    const bf16_t* res; float* out; const float* gate; const float* fg; float* xbuf; unsigned* cnt; int row_off; unsigned lds_addr;
    __device__ __forceinline__ void operator()(f32x4 (&acc)[2][2][4][2], const Unit& u, int wr, int wc, int fr, int fq, int ui) const {
        const bf16_t* const res = opq(this->res); float* const out = opq(this->out); const float* const gate = opq(this->gate); const float* const fg = opq(this->fg);
        const int b = (row_off + u.pm * BM) >> 11;
        const int col0 = u.pn * BM + wc * 32 + 8 * fq;
        const float* gp = gate + (size_t)b * 3072 + col0;
        LAS float* P = (LAS float*)(unsigned long)lds_addr;
        LAS float* R = (LAS float*)(unsigned long)(lds_addr + 4096);
        LAS unsigned* flag = (LAS unsigned*)(unsigned long)(lds_addr + 4096 + 1024);
        const int lane = fq * 16 + fr, wid = wr * 4 + wc;
#pragma unroll
        for (int ai = 0; ai < 2; ++ai)
#pragma unroll
            for (int m = 0; m < 4; ++m) {
                const int trow = ai * HALF + wr * 64 + m * 16 + fr;
                const size_t grow = (size_t)(row_off + u.pm * BM + trow);
                float ss = 0.f;
#pragma unroll
                for (int bj = 0; bj < 2; ++bj) {
                    const int co = bj * HALF;
                    const f32x4 gv0 = *(const f32x4*)(gp + co), gv1 = *(const f32x4*)(gp + co + 4);
                    f32x4 r0, r1; ld_h8(res + grow * HLD + col0 + co, r0, r1);
                    const f32x4 hn0 = r0 + gv0 * acc[ai][bj][m][0], hn1 = r1 + gv1 * acc[ai][bj][m][1];
                    acc[ai][bj][m][0] = hn0; acc[ai][bj][m][1] = hn1;
                    ss += ((hn0[0] * hn0[0] + hn0[1] * hn0[1]) + (hn0[2] * hn0[2] + hn0[3] * hn0[3])) + ((hn1[0] * hn1[0] + hn1[1] * hn1[1]) + (hn1[2] * hn1[2] + hn1[3] * hn1[3]));
                }
                ss += __shfl_xor(ss, 16); ss += __shfl_xor(ss, 32);
                if (fq == 0) P[trow * 4 + wc] = ss;
                asm volatile("" ::: "memory");
            }
        asm volatile("s_waitcnt lgkmcnt(0)" ::: "memory"); __builtin_amdgcn_s_barrier(); asm volatile("" ::: "memory");
        const int row = wid * 32 + (lane & 31);
        if (lane < 32) {
            const float t = (P[row * 4 + 0] + P[row * 4 + 1]) + (P[row * 4 + 2] + P[row * 4 + 3]);
            __hip_atomic_store(xbuf + ((size_t)(row_off + u.pm * BM + row) * 4 + u.pn), t, __ATOMIC_RELAXED, __HIP_MEMORY_SCOPE_AGENT);
        }
        asm volatile("s_waitcnt vmcnt(0)" ::: "memory");
        unsigned* cw = cnt + 64 * ((row_off >> 8) + u.pm);
        if (lane == 0) __hip_atomic_fetch_add(cw, 1u, __ATOMIC_RELAXED, __HIP_MEMORY_SCOPE_AGENT);
        if (wid == 0) {
            unsigned sp = 0; bool dead = false;
            for (;;) {
                if ((unsigned)__builtin_amdgcn_readfirstlane(__hip_atomic_load(cw, __ATOMIC_RELAXED, __HIP_MEMORY_SCOPE_AGENT)) >= 32u) break;
                __builtin_amdgcn_s_sleep(2);
                if (++sp > (1u << 22)) { dead = true; break; }
            }
            __builtin_amdgcn_fence(__ATOMIC_ACQUIRE, "agent");
            if (lane == 0) flag[0] = dead ? 1u : 0u;
        }
        asm volatile("s_waitcnt vmcnt(0) lgkmcnt(0)" ::: "memory"); __builtin_amdgcn_s_barrier(); asm volatile("" ::: "memory");
        if (lane < 32) {
            const float* slot = xbuf + (size_t)(row_off + u.pm * BM + row) * 4;
            float t = 0.f;
#pragma unroll
            for (int q = 0; q < 4; ++q) t += __hip_atomic_load(slot + q, __ATOMIC_RELAXED, __HIP_MEMORY_SCOPE_AGENT);
            R[row] = __builtin_amdgcn_rsqf(t * (1.0f / DM) + EPS);
        }
        asm volatile("s_waitcnt vmcnt(0) lgkmcnt(0)" ::: "memory"); __builtin_amdgcn_s_barrier(); asm volatile("" ::: "memory");
        const bool bad = flag[0] != 0u;
        const float qn = __builtin_nanf("");
#pragma unroll
        for (int ai = 0; ai < 2; ++ai)
#pragma unroll
            for (int m = 0; m < 4; ++m) {
                const int trow = ai * HALF + wr * 64 + m * 16 + fr;
                const size_t grow = (size_t)(row_off + u.pm * BM + trow);
                const float rs = bad ? qn : R[trow];
#pragma unroll
                for (int bj = 0; bj < 2; ++bj)
#pragma unroll
                    for (int n = 0; n < 2; ++n) {
                        const int co = bj * HALF + 4 * n;
                        const f32x4 gv = *(const f32x4*)(fg + col0 + co);
                        *(f32x4*)(out + grow * DM + col0 + co) = acc[ai][bj][m][n] * rs * gv;
                    }
                asm volatile("" ::: "memory");
            }
    }
};

template <class Epi, class Sched, bool ALIGN_EPI = false, bool SP2 = false>
__device__ __forceinline__ void gemm_phase(LAS unsigned char* lds, const Gemm g, const Sched& S, const Epi& E, const int wid) {
    const int lane = lane_id(), tid = wid * 64 + lane, wr = wid >> 2, wc = wid & 3, fr = lane & 15, fq = lane >> 4;
    const int K = g.K, nt = K / BK;
    unsigned voffA[2], voffB[2];
#pragma unroll
    for (int i = 0; i < 2; ++i) { int R, C; stage_rc(tid * 16 + i * 8192, R, C); const int Rb = Epi::PERM ? ((R & ~31) + perm32(R & 31)) : R;
        voffA[i] = (unsigned)(R * K + C) * 2u; voffB[i] = (unsigned)(Rb * K + C) * 2u; }
    const size_t kstep = (size_t)(BK * 2);
    const size_t hstep = (size_t)HALF * K * 2;
    const size_t tstep = 2 * hstep;
    const unsigned ldsw = (unsigned)wid * 1024u;
    const int aoff = lds_byte(wr * 64 + fr, fq * 8), boff = lds_byte(wc * 32 + fr, fq * 8);
#define PG8_SA(b, h) (((b) * 2 + (h)) * HTB)
#define PG8_SB(b, h) ((4 + (b) * 2 + (h)) * HTB)
#define PG8_STAGE(bufoff, gbase, voff) do { _Pragma("unroll") for (int _i = 0; _i < 2; ++_i) \
        __builtin_amdgcn_global_load_lds((const unsigned*)((const char*)(gbase) + (voff)[_i]), (LAS unsigned*)(lds + (bufoff) + ldsw + _i * 8192), 16, 0, 0); } while (0)
#define PG8_LDA(dst, b, h) do { _Pragma("unroll") for (int m = 0; m < 4; ++m) _Pragma("unroll") for (int k = 0; k < 2; ++k) dst[m][k] = *(const LAS bf16x8*)(lds + PG8_SA(b, h) + aoff + m * 2048 + k * 1024); } while (0)
#define PG8_LDB(dst, b, h) do { _Pragma("unroll") for (int n = 0; n < 2; ++n) _Pragma("unroll") for (int k = 0; k < 2; ++k) dst[n][k] = *(const LAS bf16x8*)(lds + PG8_SB(b, h) + boff + n * 2048 + k * 1024); } while (0)
#define PG8_MMA(ai, bj, At, Bt) do { __builtin_amdgcn_s_setprio(1); _Pragma("unroll") for (int m = 0; m < 4; ++m) _Pragma("unroll") for (int n = 0; n < 2; ++n) _Pragma("unroll") for (int k = 0; k < 2; ++k) \
        acc[ai][bj][m][n] = __builtin_amdgcn_mfma_f32_16x16x32_bf16(Bt[n][k], At[m][k], acc[ai][bj][m][n], 0, 0, 0); __builtin_amdgcn_s_setprio(0); } while (0)
#define PG8_WAIT_V(n) asm volatile("s_waitcnt vmcnt(" #n ")" ::: "memory")
#define PG8_WAIT_L(n) asm volatile("s_waitcnt lgkmcnt(" #n ")" ::: "memory")
#define PG8_BAR __builtin_amdgcn_s_barrier()
#define PG8_SCHED __builtin_amdgcn_sched_barrier(0)
    Unit cur, nxt; int ui = 0;
    (void)S.next(0, cur);
    f32x4 acc[2][2][4][2];
#pragma unroll
    for (int a = 0; a < 2; ++a)
#pragma unroll
        for (int b = 0; b < 2; ++b)
#pragma unroll
            for (int m = 0; m < 4; ++m)
#pragma unroll
                for (int n = 0; n < 2; ++n) acc[a][b][m][n] = (f32x4){0.f, 0.f, 0.f, 0.f};
    bf16x8 At[4][2], B0[2][2], B1[2][2];
    const char* cA = (const char*)g.A + (size_t)cur.pm * tstep; const char* cB = (const char*)g.Bt + (size_t)cur.pn * tstep;
    S.a_ready(cur);
    if constexpr (SP2) {
        PG8_STAGE(PG8_SB(0, 0), cB, voffB); PG8_STAGE(PG8_SB(0, 1), cB + hstep, voffB); PG8_STAGE(PG8_SA(0, 0), cA, voffA); PG8_STAGE(PG8_SA(0, 1), cA + hstep, voffA);
        if (wr == 1) PG8_BAR;
        PG8_WAIT_V(2); PG8_BAR;
        PG8_STAGE(PG8_SB(1, 0), cB + kstep, voffB); PG8_STAGE(PG8_SA(1, 0), cA + kstep, voffA); PG8_STAGE(PG8_SB(1, 1), cB + hstep + kstep, voffB);
        PG8_WAIT_V(6); PG8_BAR;
    } else {
        PG8_STAGE(PG8_SB(0, 0), cB, voffB); PG8_STAGE(PG8_SA(0, 0), cA, voffA); PG8_STAGE(PG8_SB(0, 1), cB + hstep, voffB); PG8_STAGE(PG8_SA(0, 1), cA + hstep, voffA);
        if (wr == 1) PG8_BAR;
        PG8_WAIT_V(4); PG8_BAR;
        PG8_STAGE(PG8_SB(1, 0), cB + kstep, voffB); PG8_STAGE(PG8_SA(1, 0), cA + kstep, voffA); PG8_STAGE(PG8_SB(1, 1), cB + hstep + kstep, voffB);
        PG8_WAIT_V(6); PG8_BAR;
    }
    for (;;) {
        const bool has_next = S.next(ui + 1, nxt);
        const char* nA = has_next ? (const char*)g.A + (size_t)nxt.pm * tstep : cA; const char* nB = has_next ? (const char*)g.Bt + (size_t)nxt.pn * tstep : cB;
        for (int t = 0; t < nt; t += 2) {
            const bool last = (t == nt - 2);
            const char* a1 = cA + (size_t)(t + 1) * kstep;
            const char* a2 = last ? nA : cA + (size_t)(t + 2) * kstep; const char* b2 = last ? nB : cB + (size_t)(t + 2) * kstep;
            const char* a3 = a2 + kstep; const char* b3 = b2 + kstep;
            if (last && has_next) S.a_ready(nxt);
            if constexpr (SP2) {
            PG8_LDB(B0, 0, 0); PG8_LDB(B1, 0, 1); PG8_SCHED; PG8_LDA(At, 0, 0); PG8_STAGE(PG8_SA(1, 1), a1 + hstep, voffA);
            PG8_WAIT_V(8); PG8_WAIT_L(0); PG8_BAR; PG8_MMA(0, 0, At, B0); PG8_MMA(0, 1, At, B1); PG8_BAR; PG8_SCHED;
            PG8_LDA(At, 0, 1); PG8_STAGE(PG8_SB(0, 0), b2, voffB); PG8_STAGE(PG8_SB(0, 1), b2 + hstep, voffB); PG8_STAGE(PG8_SA(0, 0), a2, voffA);
            PG8_WAIT_V(8); PG8_WAIT_L(0); PG8_BAR; PG8_MMA(1, 0, At, B0); PG8_MMA(1, 1, At, B1); PG8_BAR; PG8_SCHED;
            PG8_LDB(B0, 1, 0); PG8_LDB(B1, 1, 1); PG8_SCHED; PG8_LDA(At, 1, 0); PG8_STAGE(PG8_SA(0, 1), a2 + hstep, voffA);
            PG8_WAIT_V(8); PG8_WAIT_L(0); PG8_BAR; PG8_MMA(0, 0, At, B0); PG8_MMA(0, 1, At, B1); PG8_BAR; PG8_SCHED;
            PG8_LDA(At, 1, 1); PG8_STAGE(PG8_SB(1, 0), b3, voffB); PG8_STAGE(PG8_SB(1, 1), b3 + hstep, voffB); PG8_STAGE(PG8_SA(1, 0), a3, voffA);
            PG8_WAIT_V(8); PG8_WAIT_L(0); PG8_BAR; PG8_MMA(1, 0, At, B0); PG8_MMA(1, 1, At, B1); PG8_BAR; PG8_SCHED;
            } else {
            PG8_LDB(B0, 0, 0); PG8_SCHED; PG8_LDA(At, 0, 0); PG8_STAGE(PG8_SA(1, 1), a1 + hstep, voffA);
            PG8_WAIT_L(8); PG8_BAR; PG8_WAIT_L(0); PG8_MMA(0, 0, At, B0); PG8_BAR; PG8_SCHED;
            PG8_LDB(B1, 0, 1); PG8_STAGE(PG8_SB(0, 0), b2, voffB);
            PG8_BAR; PG8_WAIT_L(0); PG8_MMA(0, 1, At, B1); PG8_BAR;
            PG8_LDA(At, 0, 1); PG8_STAGE(PG8_SA(0, 0), a2, voffA);
            PG8_BAR; PG8_WAIT_L(0); PG8_MMA(1, 0, At, B0); PG8_BAR; PG8_SCHED;
            PG8_STAGE(PG8_SB(0, 1), b2 + hstep, voffB);
            PG8_WAIT_V(6); PG8_BAR; PG8_MMA(1, 1, At, B1); PG8_BAR;
            PG8_LDB(B0, 1, 0); PG8_SCHED; PG8_LDA(At, 1, 0); PG8_STAGE(PG8_SA(0, 1), a2 + hstep, voffA);
            PG8_WAIT_L(8); PG8_BAR; PG8_WAIT_L(0); PG8_MMA(0, 0, At, B0); PG8_BAR; PG8_SCHED;
            PG8_LDB(B1, 1, 1); PG8_STAGE(PG8_SB(1, 0), b3, voffB);
            PG8_BAR; PG8_WAIT_L(0); PG8_MMA(0, 1, At, B1); PG8_BAR;
            PG8_LDA(At, 1, 1); PG8_STAGE(PG8_SA(1, 0), a3, voffA);
            PG8_BAR; PG8_WAIT_L(0); PG8_MMA(1, 0, At, B0); PG8_BAR; PG8_SCHED;
            PG8_STAGE(PG8_SB(1, 1), b3 + hstep, voffB);
            PG8_WAIT_V(6); PG8_BAR; PG8_MMA(1, 1, At, B1); PG8_BAR;
            }
        }
        if constexpr (ALIGN_EPI) { if (wr == 0) PG8_BAR; }
        E(acc, cur, wr, wc, fr, fq, ui); S.done(cur);
        if (!has_next) break;
#pragma unroll
        for (int a = 0; a < 2; ++a)
#pragma unroll
            for (int b = 0; b < 2; ++b)
#pragma unroll
                for (int m = 0; m < 4; ++m)
#pragma unroll
                    for (int n = 0; n < 2; ++n) acc[a][b][m][n] = (f32x4){0.f, 0.f, 0.f, 0.f};
        cur = nxt; cA = nA; cB = nB; ++ui;
        if constexpr (ALIGN_EPI) { if (wr == 1) PG8_BAR; }
    }
    PG8_WAIT_V(0);
    if constexpr (!ALIGN_EPI) { if (wr == 0) PG8_BAR; }
    PG8_BAR;
#undef PG8_SA
#undef PG8_SB
#undef PG8_STAGE
#undef PG8_LDA
#undef PG8_LDB
#undef PG8_MMA
#undef PG8_WAIT_V
#undef PG8_WAIT_L
#undef PG8_BAR
#undef PG8_SCHED
}
}

template <class Epi>
__device__ __forceinline__ void run_gemm(LAS unsigned char* lds, const bf16_t* A, const bf16_t* Bt, int M, int N, int K, const Epi& E, const int wid) {
    pg8::Gemm g{opq(A), opq(Bt), M, N, K}; pg8::StaticOrder S; S.init(M, N, (int)gridDim.x, (int)blockIdx.x);
    int w_ = wid; asm volatile("" : "+s"(w_));
    pg8::gemm_phase<Epi, pg8::StaticOrder, true, true>(lds, g, S, E, w_);
}

constexpr int RL_OFF = 131072;
__device__ __forceinline__ void rstd_to_lds(LAS unsigned char* lds, const float* ssq, int nslots, int row_off, int M, int N, const int wid) {
    LAS float* rl = (LAS float*)(lds + RL_OFF);
    pg8::StaticOrder S; S.init(M, N, (int)gridDim.x, (int)blockIdx.x); pg8::Unit u;
    const int tid = wid * 64 + lane_id(), hf = tid >> 8, row = tid & 255;
    ssq = opq(ssq);
    for (int i = hf; ; i += 8) {
        pg8::Unit u1, u2, u3;
        const bool v0 = S.next(i, u), v1 = S.next(i + 2, u1), v2 = S.next(i + 4, u2), v3 = S.next(i + 6, u3);
        if (!v0) break;
        const float r0 = pg8::row_rstd(ssq, (size_t)(row_off + u.pm * 256 + row), nslots);
        const float r1 = v1 ? pg8::row_rstd(ssq, (size_t)(row_off + u1.pm * 256 + row), nslots) : 0.f;
        const float r2 = v2 ? pg8::row_rstd(ssq, (size_t)(row_off + u2.pm * 256 + row), nslots) : 0.f;
        const float r3 = v3 ? pg8::row_rstd(ssq, (size_t)(row_off + u3.pm * 256 + row), nslots) : 0.f;
        rl[i * 256 + row] = r0;
        if (v1) rl[(i + 2) * 256 + row] = r1;
        if (v2) rl[(i + 4) * 256 + row] = r2;
        if (v3) rl[(i + 6) * 256 + row] = r3;
    }
    __syncthreads();
}
__device__ __forceinline__ void transpose_item(const float* W, int K, int N, bf16_t* WT, int mode, LAS float* scr, int item, int lane) {
    const int nblk = N / 32, kb = item / nblk, nb = item % nblk, k0 = 64 * kb, n0 = 32 * nb;
    float tv[32];
#pragma unroll
    for (int i = 0; i < 32; ++i) { const int kk = 2 * i + (lane >> 5); tv[i] = W[(size_t)(k0 + kk) * N + n0 + (lane & 31)]; }
#pragma unroll
    for (int i = 0; i < 32; ++i) { const int kk = 2 * i + (lane >> 5); scr[kk * 33 + (lane & 31)] = tv[i]; }
    LDS_WAIT();
    int d0 = n0;
    if (mode == 1) { const int bj = n0 >> 10, rem = n0 & 1023; d0 = 256 * (rem >> 7) + 128 * bj + (rem & 127); }
    const int c = lane & 7;
#pragma unroll
    for (int j = 0; j < 4; ++j) { const int n = (lane >> 3) + 8 * j; const LAS float* s = scr + (8 * c) * 33 + n;
        u32x4 o; o.x = pk2(s[0 * 33], s[1 * 33]); o.y = pk2(s[2 * 33], s[3 * 33]); o.z = pk2(s[4 * 33], s[5 * 33]); o.w = pk2(s[6 * 33], s[7 * 33]);
        *(u32x4*)(WT + (size_t)(d0 + n) * K + k0 + 8 * c) = o; }
    LDS_WAIT();
}

__device__ __forceinline__ void gemv_load_vec(LAS float* vs, const float* vin, int ldin, bool do_silu, const int wid) {
    __syncthreads();
    for (int i = wid * 64 + lane_id(); i < 16 * 1024; i += 512) { const int b = i >> 10, k = i & 1023; float v = vin[(size_t)b * ldin + k]; if (do_silu) v = v / (1.0f + __expf(-v)); vs[k * 16 + b] = v; }
    __syncthreads();
}
__device__ __forceinline__ void gemv_item(LAS float* vs, LAS float* red, const float* W, int N, const float* bias, float* out, int cg0, const int wid) {
    const int lane = lane_id(), tid = wid * 64 + lane;
    float acc[16];
#pragma unroll
    for (int b = 0; b < 16; ++b) acc[b] = 0.f;
    const float* wp = W + (size_t)(wid * 128) * N + cg0 + lane;
    for (int k0 = 0; k0 < 128; k0 += 32) {
        float wv[32];
#pragma unroll
        for (int k = 0; k < 32; ++k) wv[k] = wp[(size_t)(k0 + k) * N];
#pragma unroll
        for (int k = 0; k < 32; ++k) {
            const LAS f32x4* v = (const LAS f32x4*)(vs + (wid * 128 + k0 + k) * 16);
#pragma unroll
            for (int q = 0; q < 4; ++q) { const f32x4 x = v[q];
#pragma unroll
                for (int j = 0; j < 4; ++j) acc[4 * q + j] += x[j] * wv[k]; }
        }
    }
#pragma unroll
    for (int b = 0; b < 16; ++b) red[(wid * 16 + b) * 64 + lane] = acc[b];
    __syncthreads();
    for (int o = tid; o < 1024; o += 512) { const int b = o >> 6, c = o & 63; float s = 0.f;
#pragma unroll
        for (int w = 0; w < 8; ++w) s += red[(w * 16 + b) * 64 + c];
        out[(size_t)b * N + cg0 + c] = s + (bias ? bias[cg0 + c] : 0.f); }
    __syncthreads();
}

__device__ __forceinline__ float wave_sum(float v) {
#pragma unroll
    for (int o = 1; o < 64; o <<= 1) v += __shfl_xor(v, o);
    return v;
}

__device__ __forceinline__ void s5_phase(LAS unsigned char* lds, const bf16_t* hs, const float* ssq, const float* shift, const float* lamb, const bf16_t* Bm, const bf16_t* Cm,
                                         const float* dskip, bf16_t* z, const int wid) {
    const int lane = lane_id(), r32 = lane & 31, hi = lane >> 5, l15 = lane & 15, quad = lane >> 4;
    if (wid >= 4) return;
    hs = opq(hs); ssq = opq(ssq); shift = opq(shift); lamb = opq(lamb); Bm = opq(Bm); Cm = opq(Cm); dskip = opq(dskip); z = opq(z);
    LAS float* BUt = (LAS float*)(lds + wid * 30208);
    LAS bf16_t* Ss = (LAS bf16_t*)(lds + wid * 30208 + 18432);
    LAS float* Us = (LAS float*)(lds + wid * 30208 + 18432 + 8704);
    LAS bf16_t* Zt = (LAS bf16_t*)(lds + wid * 30208 + 18432 + 8704 + 2048);
    for (int unit = (int)blockIdx.x * 4 + wid; unit < NB * 64; unit += (int)gridDim.x * 4) {
        const int b = unit >> 6, g = unit & 63;
        bf16x8 Bf[4], Cf[4];
#pragma unroll
        for (int nt = 0; nt < 4; ++nt) Bf[nt] = *(const bf16x8*)(Bm + (size_t)(g * 128 + 32 * nt + r32) * 16 + 8 * hi);
#pragma unroll
        for (int ks = 0; ks < 4; ++ks) Cf[ks] = *(const bf16x8*)(Cm + (size_t)(g * 16 + l15) * 128 + 32 * ks + 8 * quad);
        float sh[8];
#pragma unroll
        for (int j = 0; j < 8; ++j) sh[j] = shift[(size_t)b * 3072 + 16 * g + 8 * hi + j];
        const float lr = lamb[(g * 64 + lane) * 2], li = lamb[(g * 64 + lane) * 2 + 1];
        const float dsk = dskip[16 * g + l15];
        float s_re = 0.f, s_im = 0.f;
        const size_t rowb = (size_t)b * SEQ;
        u32x4 hv = *(const u32x4*)(hs + (rowb + r32) * DM + 16 * g + 8 * hi);
        float rs = pg8::row_rstd(ssq, rowb + r32, 16);
        for (int tt = 0; tt < SEQ / 32; ++tt) {
            const u32x4 hc = hv; const float rc = rs;
            if (tt + 1 < SEQ / 32) { const size_t rn = rowb + 32 * (tt + 1) + r32; hv = *(const u32x4*)(hs + rn * DM + 16 * g + 8 * hi); rs = pg8::row_rstd(ssq, rn, 16); }
            float uu[8];
            uu[0] = bflo(hc.x) * rc + sh[0]; uu[1] = bfhi(hc.x) * rc + sh[1]; uu[2] = bflo(hc.y) * rc + sh[2]; uu[3] = bfhi(hc.y) * rc + sh[3];
            uu[4] = bflo(hc.z) * rc + sh[4]; uu[5] = bfhi(hc.z) * rc + sh[5]; uu[6] = bflo(hc.w) * rc + sh[6]; uu[7] = bfhi(hc.w) * rc + sh[7];
            *(LAS f32x4*)(Us + r32 * 16 + 8 * hi) = (f32x4){uu[0], uu[1], uu[2], uu[3]};
            *(LAS f32x4*)(Us + r32 * 16 + 8 * hi + 4) = (f32x4){uu[4], uu[5], uu[6], uu[7]};
            u32x4 aw; aw.x = pk2(uu[0], uu[1]); aw.y = pk2(uu[2], uu[3]); aw.z = pk2(uu[4], uu[5]); aw.w = pk2(uu[6], uu[7]);
            const bf16x8 af = __builtin_bit_cast(bf16x8, aw);
#pragma unroll
            for (int nt = 0; nt < 4; ++nt) {
                f32x16 a = {}; a = MFMA32(af, Bf[nt], a);
#pragma unroll
                for (int i = 0; i < 4; ++i) *(LAS f32x4*)(BUt + (32 * nt + r32) * 36 + 8 * i + 4 * hi) = (f32x4){a[4 * i], a[4 * i + 1], a[4 * i + 2], a[4 * i + 3]};
            }
            LDS_WAIT();
            f32x4 bre[8], bim[8];
#pragma unroll
            for (int q = 0; q < 8; ++q) { bre[q] = *(const LAS f32x4*)(BUt + lane * 36 + 4 * q); bim[q] = *(const LAS f32x4*)(BUt + (64 + lane) * 36 + 4 * q); }
#pragma unroll
            for (int q = 0; q < 8; ++q)
#pragma unroll
                for (int j = 0; j < 4; ++j) {
                    float t1, t2, nre, nim;
                    asm("v_fma_f32 %0, -%1, %2, %3" : "=v"(t1) : "v"(li), "v"(s_im), "v"(bre[q][j]));
                    asm("v_fma_f32 %0, %1, %2, %3" : "=v"(t2) : "v"(li), "v"(s_re), "v"(bim[q][j]));
                    asm("v_fma_f32 %0, %1, %2, %3" : "=v"(nre) : "v"(lr), "v"(s_re), "v"(t1));
                    asm("v_fma_f32 %0, %1, %2, %3" : "=v"(nim) : "v"(lr), "v"(s_im), "v"(t2));
                    s_re = nre; s_im = nim;
                    *(LAS unsigned*)(Ss + (4 * q + j) * 136 + 2 * lane) = pk2(s_re, s_im);
                }
            LDS_WAIT();
            f32x4 y0 = {0.f, 0.f, 0.f, 0.f}, y1 = {0.f, 0.f, 0.f, 0.f};
#pragma unroll
            for (int ks = 0; ks < 4; ++ks) {
                const bf16x8 s0 = *(const LAS bf16x8*)(Ss + l15 * 136 + 32 * ks + 8 * quad);
                const bf16x8 s1 = *(const LAS bf16x8*)(Ss + (16 + l15) * 136 + 32 * ks + 8 * quad);
                y0 = __builtin_amdgcn_mfma_f32_16x16x32_bf16(s0, Cf[ks], y0, 0, 0, 0);
                y1 = __builtin_amdgcn_mfma_f32_16x16x32_bf16(s1, Cf[ks], y1, 0, 0, 0);
            }
#pragma unroll
            for (int mt = 0; mt < 2; ++mt) {
                float zz[4];
#pragma unroll
                for (int j = 0; j < 4; ++j) { const int t = 16 * mt + 4 * quad + j; const float uval = Us[t * 16 + l15];
                    const float v = (mt == 0 ? y0[j] : y1[j]) + dsk * uval;
                    const float inner = 0.7978845608028654f * (v + 0.044715f * v * v * v);
                    const float e = __builtin_amdgcn_exp2f(-2.0f * 1.4426950408889634f * inner);
                    zz[j] = v * __builtin_amdgcn_rcpf(1.0f + e); }
                const unsigned w0 = pk2(zz[0], zz[1]), w1 = pk2(zz[2], zz[3]);
                const int t0 = 16 * mt + 4 * quad;
                Zt[(t0 + 0) * 16 + l15] = (bf16_t)(w0 & 0xffffu); Zt[(t0 + 1) * 16 + l15] = (bf16_t)(w0 >> 16);
                Zt[(t0 + 2) * 16 + l15] = (bf16_t)(w1 & 0xffffu); Zt[(t0 + 3) * 16 + l15] = (bf16_t)(w1 >> 16);
            }
            LDS_WAIT();
            { const int t = lane >> 1, hf = lane & 1; const u32x4 v = *(const LAS u32x4*)(Zt + t * 16 + hf * 8);
              *(u32x4*)(z + (rowb + 32 * tt + t) * DM + 16 * g + hf * 8) = v; }
            LDS_WAIT();
        }
    }
}

struct AttnU { int br, cc, h, bl; };
__device__ __forceinline__ AttnU attn_decode(int unit) { AttnU u; u.cc = ((unit & 7) + (unit >> 8)) & 7; u.h = (unit >> 3) & 15; u.bl = (unit >> 7) & 7; u.br = unit >> 10; return u; }
__device__ __forceinline__ void attn_wave_params(const AttnU& u, int wid, int& dil, int& q0, int& resw, int& slot0) {
    if (u.br == 0) { dil = 1; resw = 0; q0 = 256 * u.cc + 32 * wid; slot0 = 32 * wid; }
    else if (u.br == 1) { dil = 4; resw = u.cc >> 1; q0 = 256 * (u.cc & 1) + 32 * wid; slot0 = 32 * wid; }
    else { dil = 16; resw = 2 * u.cc + (wid >> 2); q0 = 32 * (wid & 3); slot0 = (wid >> 2) * 128 + q0 - 128; }
}
__device__ __forceinline__ void attn_issue_loads(const bf16_t* kv, const bf16_t* qo, const AttnU& u, int wid, int lane, u32x4 (&kreg)[6], u32x4 (&vreg)[6], bf16x8 (&qf)[4]) {
    const int tid = wid * 64 + lane, r32 = lane & 31, hi = lane >> 5;
    int kt0, smin, smax;
    if (u.br == 0) { kt0 = 256 * u.cc - 128; smin = kt0 < 0 ? 128 : 0; smax = 384; }
    else if (u.br == 1) { const int Kb = 256 * (u.cc & 1) - 128; kt0 = (u.cc >> 1) * 512 + Kb; smin = Kb < 0 ? 128 : 0; smax = 384; }
    else { kt0 = 2 * u.cc * 128; smin = 0; smax = 256; }
    const size_t tokb = (size_t)u.bl * SEQ;
    const bf16_t* kbase = kv + ((size_t)(u.br * 16 + u.h) * MH + tokb) * 64;
    const bf16_t* vbase = kv + ((size_t)((3 + u.br) * 16 + u.h) * MH + tokb) * 64;
#pragma unroll
    for (int i = 0; i < 6; ++i) {
        const int idx = tid + 512 * i, s = idx >> 3, c = idx & 7;
        const bool ok = s >= smin && s < smax;
        kreg[i] = (u32x4){0, 0, 0, 0}; vreg[i] = (u32x4){0, 0, 0, 0};
        if (ok) { kreg[i] = *(const u32x4*)(kbase + (ptrdiff_t)(kt0 + s) * 64 + 8 * c); vreg[i] = *(const u32x4*)(vbase + (ptrdiff_t)(kt0 + s) * 64 + 8 * c); }
    }
    int dl, q0, resw, slot0; attn_wave_params(u, wid, dl, q0, resw, slot0);
    const int sub = SEQ / dl;
    const bf16_t* qp = qo + ((size_t)(u.br * 16 + u.h) * MH + tokb + (size_t)resw * sub + q0 + r32) * 64;
#pragma unroll
    for (int d0 = 0; d0 < 4; ++d0) qf[d0] = *(const bf16x8*)(qp + 16 * d0 + 8 * hi);
}
__device__ __forceinline__ void attn_compute(LAS unsigned char* lds, bf16_t* qo, float* lse, const AttnU& u, const bf16x8 (&qf)[4], int wid, int lane) {
    const int r32 = lane & 31, hi = lane >> 5;
    LAS unsigned char* Kimg = lds; LAS unsigned char* Vimg = lds + 49152;
    LAS float* wsf = (LAS float*)(lds + 98304) + wid * 32;
    LAS bf16_t* stg = (LAS bf16_t*)(lds + 98304 + 1024 + wid * 4096);
    int dil, q0, resw, slot0; attn_wave_params(u, wid, dil, q0, resw, slot0);
    const int tstart = (128 - q0) > 0 ? ((128 - q0) >> 5) : 0;
    const size_t tokb = (size_t)u.bl * SEQ;
    const size_t qrow = tokb + (size_t)(q0 + r32) * dil + resw;
    const int tb = slot0 >> 5;
    f32x16 p[5];
    float mx = -1e30f;
#pragma unroll
    for (int t = 0; t < 5; ++t) {
        if (t >= tstart) {
            f32x16 a = {};
            const LAS unsigned char* kb = Kimg + ((tb + t) * 32 + r32) * 128;
#pragma unroll
            for (int d0 = 0; d0 < 4; ++d0) { const bf16x8 kf = *(const LAS bf16x8*)(kb + (((2 * d0 + hi) ^ ((r32 >> 1) & 7)) << 4)); a = MFMA32(kf, qf[d0], a); }
            if (t == 0) {
#pragma unroll
                for (int r = 0; r < 16; ++r) if (crow(r, hi) < r32) a[r] = -1e30f;
            }
            if (t == 4) {
#pragma unroll
                for (int r = 0; r < 16; ++r) if (crow(r, hi) > r32) a[r] = -1e30f;
            }
#pragma unroll
            for (int r = 0; r < 16; ++r) mx = fmaxf(mx, a[r]);
            p[t] = a;
        } else {
#pragma unroll
            for (int r = 0; r < 16; ++r) p[t][r] = -1e30f;
        }
    }
    mx = fmaxf(mx, __shfl_xor(mx, 32));
    float lsum = 0.f;
#pragma unroll
    for (int t = 0; t < 5; ++t)
#pragma unroll
        for (int r = 0; r < 16; ++r) { const float e = __builtin_amdgcn_exp2f(p[t][r] - mx); p[t][r] = e; lsum += e; }
    lsum += __shfl_xor(lsum, 32);
    f32x16 o[2]; o[0] = (f32x16){}; o[1] = (f32x16){};
    const int vlane = ((lane >> 4) & 1) * 32 + (lane & 3) * 8 + (4 * hi + ((lane & 15) >> 2)) * 64;
#pragma unroll
    for (int t = 0; t < 5; ++t) {
        if (t >= tstart) {
            const int sb = slot0 + 32 * t;
#pragma unroll
            for (int ks = 0; ks < 2; ++ks) {
                u32x4 pw; pw.x = pk2(p[t][8 * ks + 0], p[t][8 * ks + 1]); pw.y = pk2(p[t][8 * ks + 2], p[t][8 * ks + 3]); pw.z = pk2(p[t][8 * ks + 4], p[t][8 * ks + 5]); pw.w = pk2(p[t][8 * ks + 6], p[t][8 * ks + 7]);
                const bf16x8 pa = __builtin_bit_cast(bf16x8, pw);
#pragma unroll
                for (int dh = 0; dh < 2; ++dh) {
                    const LAS unsigned char* vp = Vimg + dh * 24576 + (sb + 16 * ks) * 64 + vlane;
                    const s16x4 lo = __builtin_bit_cast(s16x4, __builtin_amdgcn_ds_read_tr16_b64_v4i16((LAS s16x4*)vp));
                    const s16x4 hh = __builtin_bit_cast(s16x4, __builtin_amdgcn_ds_read_tr16_b64_v4i16((LAS s16x4*)(vp + 512)));
                    const bf16x8 vf = (bf16x8){lo[0], lo[1], lo[2], lo[3], hh[0], hh[1], hh[2], hh[3]};
                    o[dh] = MFMA32(pa, vf, o[dh]);
                }
            }
        }
    }
    const float linv = 1.0f / lsum;
    if (hi == 0) { wsf[r32] = linv; lse[qrow * 48 + u.br * 16 + u.h] = (mx + __builtin_amdgcn_logf(lsum)) * 0.6931471805599453f; }
    LDS_WAIT();
#pragma unroll
    for (int r = 0; r < 16; ++r) { const int orow = crow(r, hi); const float li_ = wsf[orow];
#pragma unroll
        for (int dh = 0; dh < 2; ++dh) stg[orow * 64 + dh * 32 + r32] = (bf16_t)f2bf(o[dh][r] * li_); }
    LDS_WAIT();
#pragma unroll
    for (int i = 0; i < 4; ++i) { const int row = i * 8 + (lane >> 3), ch = lane & 7; const u32x4 v = *(const LAS u32x4*)(stg + row * 64 + ch * 8);
        *(u32x4*)(qo + ((size_t)(u.br * 16 + u.h) * MH + tokb + (size_t)resw * (SEQ / dil) + q0 + row) * 64 + ch * 8) = v; }
    LDS_WAIT();
}
__device__ __forceinline__ void attn_phase(LAS unsigned char* lds, bf16_t* qo, const bf16_t* kv, float* lse, const int wid) {
    const int G = (int)gridDim.x, bx = (int)blockIdx.x; const int vcu = (G % 8 == 0) ? (bx % 8) * (G / 8) + bx / 8 : bx;
    qo = opq(qo); kv = opq(kv); lse = opq(lse);
    constexpr int NUNITS = 3 * 8 * 16 * 8;
    LAS unsigned char* Kimg = lds; LAS unsigned char* Vimg = lds + 49152;
    u32x4 kreg[6], vreg[6]; bf16x8 qn[4];
    int unit = vcu;
    if (unit < NUNITS) { const AttnU u0 = attn_decode(unit); attn_issue_loads(kv, qo, u0, wid, lane_id(), kreg, vreg, qn); }
    for (; unit < NUNITS; unit += G) {
        int lane = lane_id();
        const AttnU u = attn_decode(unit);
        { const int tid = wid * 64 + lane;
#pragma unroll
          for (int i = 0; i < 6; ++i) {
            const int idx = tid + 512 * i, s = idx >> 3, c = idx & 7;
            *(LAS u32x4*)(Kimg + s * 128 + ((c ^ ((s >> 1) & 7)) << 4)) = kreg[i];
            *(LAS u32x4*)(Vimg + (c >> 2) * 24576 + s * 64 + (c & 3) * 16) = vreg[i];
          } }
        bf16x8 qc[4];
#pragma unroll
        for (int d0 = 0; d0 < 4; ++d0) qc[d0] = qn[d0];
        __syncthreads();
        if (unit + G < NUNITS) { const AttnU un = attn_decode(unit + G); attn_issue_loads(kv, qo, un, wid, lane, kreg, vreg, qn); }
        attn_compute(lds, qo, lse, u, qc, wid, lane);
        __syncthreads();
    }
}

#define XB_TMO      128
#define XB_XCNT(j)  (256  + 64 * (j))
#define XB_XSUB(j)  (1280 + 64 * (j))
#define XB_XGEN(j)  (2304 + 64 * (j))
#define XB_TOP      3328
#define XB_TOPGEN   3392
#define XCD_BAR_WORDS 3456
#define XB_SPIN_CAP (1u << 20)
__device__ __forceinline__ unsigned xb_ld(unsigned* p)              { return __hip_atomic_load(p, __ATOMIC_RELAXED, __HIP_MEMORY_SCOPE_AGENT); }
__device__ __forceinline__ unsigned xb_add(unsigned* p, unsigned v) { return __hip_atomic_fetch_add(p, v, __ATOMIC_RELAXED, __HIP_MEMORY_SCOPE_AGENT); }
__device__ __forceinline__ unsigned xb_xcc_id() { return (unsigned)__builtin_amdgcn_s_getreg((3 << 11) | 20) & 0xFu; }
#define XB_SPIN(cond, bar) do { unsigned _sp = 0; while (cond) { __builtin_amdgcn_s_sleep(1); \
    if ((++_sp & 255u) == 0u) { if (xb_ld(&(bar)[XB_TMO])) break; if (_sp > XB_SPIN_CAP) { atomicAdd(&(bar)[XB_TMO], 1u); break; } } } } while (0)
struct XcdBarrier { unsigned* bar; unsigned x; volatile LAS unsigned* st; };
__device__ __forceinline__ void xcd_barrier_complete(unsigned* bar, unsigned x, unsigned& nloc, unsigned& nx) {
    const unsigned G = gridDim.x;
    unsigned sum, cnt, mine, sp = 0u;
    for (;;) {
        sum = 0u; cnt = 0u; mine = 0u;
#pragma unroll
        for (unsigned j = 0; j < 16; ++j) { const unsigned c = xb_ld(&bar[XB_XCNT(j)]); sum += c; cnt += (c > 0u) ? 1u : 0u; mine = (j == x) ? c : mine; }
        if (sum == G) break;
        __builtin_amdgcn_s_sleep(1);
        if ((++sp & 255u) == 0u) { if (xb_ld(&bar[XB_TMO])) break; if (sp > XB_SPIN_CAP) { atomicAdd(&bar[XB_TMO], 1u); break; } }
    }
    nloc = mine > 0u ? mine : 1u; nx = cnt > 0u ? cnt : 1u;
}
__device__ __forceinline__ void xcd_barrier(const XcdBarrier& b, const bool leader) {
    asm volatile("s_waitcnt vmcnt(0)" ::: "memory");
    __syncthreads();
    if (leader) {
        unsigned* bar = b.bar;
        __builtin_amdgcn_s_waitcnt(0);
        unsigned nloc = b.st[0], nx = b.st[1];
        if (nloc == 0u) { xcd_barrier_complete(bar, b.x, nloc, nx); b.st[0] = nloc; b.st[1] = nx; }
        const unsigned old = xb_add(&bar[XB_XSUB(b.x)], 1u);
        const unsigned gen = old / nloc;
        if (old + 1u == (gen + 1u) * nloc) {
            __builtin_amdgcn_fence(__ATOMIC_RELEASE, "agent");
            asm volatile("s_waitcnt vmcnt(0)" ::: "memory");
            const unsigned og = xb_add(&bar[XB_TOP], 1u);
            const unsigned tg = og / nx;
            if (og + 1u == (tg + 1u) * nx) xb_add(&bar[XB_TOPGEN], 1u);
            else XB_SPIN(xb_ld(&bar[XB_TOPGEN]) == tg, bar);
            __builtin_amdgcn_fence(__ATOMIC_ACQUIRE, "agent");
            xb_add(&bar[XB_XGEN(b.x)], 1u);
            asm volatile("s_waitcnt vmcnt(0)" ::: "memory");
        } else {
            XB_SPIN(xb_ld(&bar[XB_XGEN(b.x)]) == gen, bar);
            __builtin_amdgcn_fence(__ATOMIC_ACQUIRE, "agent");
            asm volatile("s_waitcnt vmcnt(0)" ::: "memory");
        }
    }
    __syncthreads();
}

struct Args { const float* in[23]; float* out; unsigned char* ws; int ph_lo, ph_hi; };

__global__ void __launch_bounds__(512, 2) fwd(Args a) {
    extern __shared__ __attribute__((aligned(16))) unsigned char lds_raw[];
    LAS unsigned char* lds = (LAS unsigned char*)lds_raw;
    const int wid = __builtin_amdgcn_readfirstlane((int)threadIdx.x >> 6);
    if (a.ph_lo < 0) cg::this_grid().sync();
    const int G = (int)gridDim.x, bx = (int)blockIdx.x;
    volatile LAS unsigned* bst = (volatile LAS unsigned*)(lds + LDS_BYTES - 64);
    XcdBarrier bar; bar.bar = (unsigned*)a.ws; bar.x = xb_xcc_id(); bar.st = bst;
    { const int tid0 = wid * 64 + lane_id();
      if (tid0 < 16) bst[tid0] = 0u;
      __syncthreads();
      if (a.ph_hi - a.ph_lo > 1) { if (tid0 == 0) (void)xb_add(&bar.bar[XB_XCNT(bar.x)], 1u); } }
    const int gw = bx * 8 + wid, NGW = G * 8;
    unsigned char* ws = a.ws;
    const float* x = a.in[0]; const float* cvec = a.in[1]; const float* ln_g = a.in[2]; const float* ada_w = a.in[3]; const float* ada_b = a.in[4];
    const float* lam_re = a.in[5]; const float* lam_im = a.in[6]; const float* log_dt = a.in[7]; const float* b_re = a.in[8]; const float* b_im = a.in[9];
    const float* c_re = a.in[10]; const float* c_im = a.in[11]; const float* ssm_d = a.in[12]; const float* w_glu = a.in[13]; const float* kv_g = a.in[14];
    const float* kv_ada_w = a.in[15]; const float* kv_ada_b = a.in[16]; const float* w_kv = a.in[17]; const float* w_q = a.in[18]; const float* w_o = a.in[19];
    const float* w1 = a.in[20]; const float* w2 = a.in[21]; const float* final_g = a.in[22];
    bf16_t* hbuf = (bf16_t*)a.out;
    float* mods = (float*)(ws + WS_MODS); float* kvmods = (float*)(ws + WS_KVMODS); float* GM = (float*)(ws + WS_GM);
    float* sw1 = (float*)(ws + WS_SW1); float* swq = (float*)(ws + WS_SWQ); float* swkv = (float*)(ws + WS_SWKV);
    float* lamb = (float*)(ws + WS_LAMB); bf16_t* Bm = (bf16_t*)(ws + WS_BM); bf16_t* Cm = (bf16_t*)(ws + WS_CM);
    float* lse = (float*)(ws + WS_LSE); float* ssq = (float*)(ws + WS_SSQ);
    bf16_t* wkv_t = (bf16_t*)(ws + WS_WKV); bf16_t* wq_t = (bf16_t*)(ws + WS_WQ); bf16_t* wo_t = (bf16_t*)(ws + WS_WO);
    bf16_t* wglu_t = (bf16_t*)(ws + WS_WGLU);
    bf16_t* hs = (bf16_t*)(ws + WS_HS); bf16_t* hskv0 = (bf16_t*)(ws + WS_HSKV0); bf16_t* hskv1 = (bf16_t*)(ws + WS_HSKV1);
    bf16_t* qbuf = (bf16_t*)(ws + WS_Q); bf16_t* obuf = (bf16_t*)(ws + WS_O); bf16_t* acth = (bf16_t*)(ws + WS_ACTH); bf16_t* kvh = (bf16_t*)(ws + WS_KVH);
    bf16_t* zbuf = (bf16_t*)(ws + WS_Z); bf16_t* actf = (bf16_t*)(ws + WS_ACTF);
#define W1T(l) ((bf16_t*)(ws + ((l) < 2 ? WS_W1A + (size_t)(l) * 8 * MiB : WS_W1B + (size_t)((l) - 2) * 8 * MiB)))
#define W2T(l) ((bf16_t*)(ws + ((l) < 2 ? WS_W2A + (size_t)(l) * 8 * MiB : WS_W2B + (size_t)((l) - 2) * 8 * MiB)))
#define MODS(l, j) (mods + (size_t)((l) * 2 + (j)) * 16 * 3072)
#define GMT(idx) (GM + (size_t)(idx) * 16 * DM)

    int ph = 0; const int lo = a.ph_lo, hi_ = a.ph_hi;
#ifndef PROBE_DUP
#define PROBE_DUP 0
#endif
#define PH_BEGIN if (ph >= lo && ph < hi_) {
#define PH_BEGIN_G(g) if (ph >= lo && ph < hi_) for (int rep_ = 0; rep_ <= ((PROBE_DUP >> (g)) & 1); ++rep_) {
#define PH_END } ++ph; if (ph > lo && ph < hi_) xcd_barrier(bar, wid == 0 && lane_id() == 0);

    PH_BEGIN_G(0)
    {
        const int lane = lane_id(), tid = wid * 64 + lane;
        LAS float* scr = (LAS float*)(lds + wid * 8448);
        for (int it = gw; it < 16 * 64; it += NGW) transpose_item(w_glu, 1024, 2048, wglu_t, 1, scr, it, lane);
        for (int i = bx * 512 + tid; i < 2 * 64 * 64; i += G * 512) {
            const int p = i & 63, g = (i >> 6) & 63, l = i >> 12;
            const double dt = exp_d((double)log_dt[l * 64 + g]);
            const double lre = (double)lam_re[i], lim = (double)lam_im[i];
            const double ea = exp_d(lre * dt); double sn, cs; sincos_d(lim * dt, sn, cs);
            const double are = ea * cs, aim = ea * sn;
            lamb[i * 2] = (float)are; lamb[i * 2 + 1] = (float)aim;
            const double nre = are - 1.0, nim = aim, den = lre * lre + lim * lim;
            const double fre = (nre * lre + nim * lim) / den, fim = (nim * lre - nre * lim) / den;
            const size_t lg = (size_t)(l * 64 + g);
            for (int c = 0; c < 16; ++c) {
                const double br_ = (double)b_re[(size_t)i * 16 + c], bi_ = (double)b_im[(size_t)i * 16 + c];
                Bm[(lg * 128 + p) * 16 + c] = (bf16_t)f2bf((float)(fre * br_ - fim * bi_));
                Bm[(lg * 128 + 64 + p) * 16 + c] = (bf16_t)f2bf((float)(fre * bi_ + fim * br_));
                Cm[(lg * 16 + c) * 128 + 2 * p] = (bf16_t)f2bf(c_re[(lg * 16 + c) * 64 + p]);
                Cm[(lg * 16 + c) * 128 + 2 * p + 1] = (bf16_t)f2bf(-c_im[(lg * 16 + c) * 64 + p]);
            }
        }
        LAS float* vs = (LAS float*)lds; LAS float* red = (LAS float*)(lds + 65536);
        gemv_load_vec(vs, cvec, 1024, true, wid);
        for (int it = bx; it < 8 * 48 + 32; it += G) {
            if (it < 8 * 48) { const int mi = it / 48, cgp = it % 48; gemv_item(vs, red, ada_w + (size_t)mi * 1024 * 3072, 3072, ada_b + (size_t)mi * 3072, mods + (size_t)mi * 16 * 3072, cgp * 64, wid); }
            else { const int cgp = it - 8 * 48; gemv_item(vs, red, kv_ada_w, 2048, kv_ada_b, kvmods, cgp * 64, wid); }
        }
    }
    PH_END

    PH_BEGIN_G(1)
    {
        const int lane = lane_id(), tid = wid * 64 + lane;
        for (int i = bx * 512 + tid; i < 9 * 16 * DM; i += G * 512) {
            const int k = i & 1023, b = (i >> 10) & 15, idx = i >> 14;
            float gv, sc;
            if (idx < 8) { gv = ln_g[idx * DM + k]; sc = mods[((size_t)idx * 16 + b) * 3072 + 1024 + k]; } else { gv = kv_g[k]; sc = kvmods[(size_t)b * 2048 + 1024 + k]; }
            GM[i] = gv * (1.0f + sc);
        }
        LAS float* vs = (LAS float*)lds; LAS float* red = (LAS float*)(lds + 65536);
        for (int it = bx; it < 448; it += G) {
            if (it < 256) { const int l = it >> 6, cgp = it & 63; gemv_load_vec(vs, MODS(l, 1), 3072, false, wid); gemv_item(vs, red, w1 + (size_t)l * 1024 * FF, FF, nullptr, sw1 + (size_t)l * 16 * FF, cgp * 64, wid); }
            else if (it < 352) { const int j = (it - 256) / 48, cgp = (it - 256) % 48; gemv_load_vec(vs, MODS(2 + j, 0), 3072, false, wid); gemv_item(vs, red, w_q + (size_t)j * 1024 * QW, QW, nullptr, swq + (size_t)j * 16 * QW, cgp * 64, wid); }
            else { const int cgp = it - 352; gemv_load_vec(vs, kvmods, 2048, false, wid); gemv_item(vs, red, w_kv, KVW, nullptr, swkv, cgp * 64, wid); }
        }
        for (int m = gw; m < MTOK; m += NGW) {
            const int b = m >> 11; const f32x4* xr = (const f32x4*)(x + (size_t)m * DM) + lane;
            f32x4 v[4]; float s = 0.f;
#pragma unroll
            for (int j = 0; j < 4; ++j) { v[j] = xr[64 * j]; s += (v[j][0] * v[j][0] + v[j][1] * v[j][1]) + (v[j][2] * v[j][2] + v[j][3] * v[j][3]); }
            s = wave_sum(s);
            if (lane < 16) ssq[(size_t)m * SSQ_LD + lane] = lane == 0 ? s : 0.f;
#pragma unroll
            for (int j = 0; j < 4; ++j) { const int k = 4 * lane + 256 * j;
                const f32x4 gv = *(const f32x4*)(ln_g + k); const f32x4 sc = *(const f32x4*)(mods + (size_t)b * 3072 + 1024 + k);
                const f32x4 hv = v[j] * (gv * (1.0f + sc)); u32x2 w; w.x = pk2(hv[0], hv[1]); w.y = pk2(hv[2], hv[3]);
                *(u32x2*)(hs + (size_t)m * DM + k) = w; }
        }
    }
    PH_END

    for (int l = 0; l < 2; ++l) {
        PH_BEGIN_G(2)
#ifndef NO_S5
        if (wid >= 4) {
            const int lane = lane_id();
            LAS float* scr = (LAS float*)(lds + 4 * 30208 + (wid - 4) * 8448);
            const int gw4 = bx * 4 + (wid - 4), NGW4 = G * 4;
            constexpr int I_GLU = 16 * 64, I_KV = 16 * 192, I_Q = 16 * 96, I_O = 16 * 32, I_1 = 16 * 128, I_2 = 64 * 32;
            constexpr int NITEMS = I_GLU + I_KV + 2 * I_Q + 2 * I_O + 4 * I_1 + 4 * I_2;
            const int nset = l == 0 ? 9216 : NITEMS - 9216;
            for (int k = gw4; k < nset; k += NGW4) {
                int r;
                if (l == 0) r = k < 4096 ? k : (k < 8192 ? 8192 + (k - 4096) : 16384 + (k - 8192));
                else        r = k < 4096 ? 4096 + k : (k < 8192 ? 12288 + (k - 4096) : 17408 + (k - 8192));
                if (r < 4 * I_1) { const int li = r / I_1; transpose_item(w1 + (size_t)li * 1024 * FF, 1024, FF, W1T(li), 0, scr, r % I_1, lane); continue; } r -= 4 * I_1;
                if (r < 4 * I_2) { const int li = r / I_2; transpose_item(w2 + (size_t)li * FF * 1024, FF, 1024, W2T(li), 0, scr, r % I_2, lane); continue; } r -= 4 * I_2;
                if (r < I_GLU) { transpose_item(w_glu + (size_t)1024 * 2048, 1024, 2048, wglu_t + (size_t)2048 * 1024, 1, scr, r, lane); continue; } r -= I_GLU;
                if (r < I_KV) { transpose_item(w_kv, 1024, KVW, wkv_t, 0, scr, r, lane); continue; } r -= I_KV;
                if (r < 2 * I_Q) { const int li = r / I_Q; transpose_item(w_q + (size_t)li * 1024 * QW, 1024, QW, wq_t + (size_t)li * QW * 1024, 0, scr, r % I_Q, lane); continue; } r -= 2 * I_Q;
                { const int li = r / I_O; transpose_item(w_o + (size_t)li * 1024 * 1024, 1024, 1024, wo_t + (size_t)li * 1024 * 1024, 0, scr, r % I_O, lane); }
            }
        }
        s5_phase(lds, hs, ssq, MODS(l, 0), lamb + (size_t)l * 64 * 64 * 2, Bm + (size_t)l * 64 * 128 * 16, Cm + (size_t)l * 64 * 16 * 128, ssm_d + (size_t)l * DM, zbuf, wid);
#endif
        PH_END
        PH_BEGIN
        { pg8::EpiGlu E{l == 0 ? (const void*)x : (const void*)hbuf, l == 0 ? 1 : 0, hbuf, hs, MODS(l, 0) + 2048, GMT(l * 2 + 1), ssq, 0};
          run_gemm(lds, zbuf, wglu_t + (size_t)l * 2048 * 1024, MTOK, 2048, 1024, E, wid); }
        PH_END
        PH_BEGIN_G(3)
        { rstd_to_lds(lds, ssq, 32, 0, MTOK, FF, wid);
          pg8::EpiAct E{actf, FF, ssq, 32, sw1 + (size_t)l * 16 * FF, 0, 1, 1.0f, 0, (unsigned)(unsigned long)(lds + RL_OFF)};
          run_gemm(lds, hs, W1T(l), MTOK, FF, 1024, E, wid); }
        PH_END
        PH_BEGIN
        { pg8::EpiRes E{hbuf, hbuf, hs, MODS(l, 1) + 2048, GMT(l * 2 + 2), ssq, 0, hskv0, hskv1, l == 1 ? GMT(8) : nullptr};
          run_gemm(lds, actf, W2T(l), MTOK, 1024, FF, E, wid); }
        PH_END
    }

    for (int hb = 0; hb < 2; ++hb) {
        const int ro = hb * MH;
        const bf16_t* hskv = hb == 0 ? hskv0 : hskv1;
        for (int l = 2; l < 4; ++l) {
            const int j = l - 2;
            PH_BEGIN_G(4)
            if (l == 2) { rstd_to_lds(lds, ssq, 16, ro, MH, KVW, wid);
                pg8::EpiAct E{kvh, KVW, ssq, 16, swkv, ro, 0, 1.0f, 1, (unsigned)(unsigned long)(lds + RL_OFF)}; run_gemm(lds, hskv, wkv_t, MH, KVW, 1024, E, wid); }
            { rstd_to_lds(lds, ssq, 16, ro, MH, QW, wid);
              pg8::EpiAct E{qbuf, QW, ssq, 16, swq + (size_t)j * 16 * QW, ro, 0, C2, 1, (unsigned)(unsigned long)(lds + RL_OFF)}; run_gemm(lds, hs + (size_t)ro * DM, wq_t + (size_t)j * QW * 1024, MH, QW, 1024, E, wid); }
            PH_END
            PH_BEGIN
#ifndef NO_ATTN
            attn_phase(lds, qbuf, kvh, lse, wid);
            if ((PROBE_DUP >> 7) & 1) {
                xcd_barrier(bar, wid == 0 && lane_id() == 0);
                { pg8::EpiAct E{qbuf, QW, ssq, 16, swq + (size_t)j * 16 * QW, ro, 0, C2, 1}; run_gemm(lds, hs + (size_t)ro * DM, wq_t + (size_t)j * QW * 1024, MH, QW, 1024, E, wid); }
                xcd_barrier(bar, wid == 0 && lane_id() == 0);
                attn_phase(lds, qbuf, kvh, lse, wid);
            }
            if ((PROBE_DUP >> 8) & 1) { for (int rb = 0; rb < 10; ++rb) xcd_barrier(bar, wid == 0 && lane_id() == 0); }
#endif
            PH_END
            PH_BEGIN_G(5)
            const int lane = lane_id();
            for (int m = gw; m < MH; m += NGW) {
                const int h = lane >> 2; const float* lp = lse + (size_t)m * 48 + h;
                const float l0 = lp[0], l1 = lp[16], l2 = lp[32]; const float mm = fmaxf(l0, fmaxf(l1, l2));
                float e0 = __expf(l0 - mm), e1 = __expf(l1 - mm), e2 = __expf(l2 - mm); const float inv = 1.0f / (e0 + e1 + e2); e0 *= inv; e1 *= inv; e2 *= inv;
                const int mb = m & ~2047, pos = m & 2047, dd = (lane & 3) * 16;
                const bf16_t* q0p = qbuf + ((size_t)(0 * 16 + h) * MH + mb + pos) * 64 + dd;
                const bf16_t* q1p = qbuf + ((size_t)(1 * 16 + h) * MH + mb + pg8::perm_pos(1, pos)) * 64 + dd;
                const bf16_t* q2p = qbuf + ((size_t)(2 * 16 + h) * MH + mb + pg8::perm_pos(2, pos)) * 64 + dd;
#pragma unroll
                for (int c = 0; c < 2; ++c) { const u32x4 a0 = *(const u32x4*)(q0p + 8 * c), a1 = *(const u32x4*)(q1p + 8 * c), a2 = *(const u32x4*)(q2p + 8 * c);
                    u32x4 w;
#pragma unroll
                    for (int q = 0; q < 4; ++q) { const float lo_ = e0 * bflo(a0[q]) + e1 * bflo(a1[q]) + e2 * bflo(a2[q]); const float hi2 = e0 * bfhi(a0[q]) + e1 * bfhi(a1[q]) + e2 * bfhi(a2[q]); w[q] = pk2(lo_, hi2); }
                    *(u32x4*)(obuf + (size_t)m * DM + 16 * lane + 8 * c) = w; }
            }
            PH_END
            PH_BEGIN
            { pg8::EpiRes E{hbuf, hbuf, hs, MODS(l, 0) + 2048, GMT(l * 2 + 1), ssq, ro, nullptr, nullptr, nullptr};
              run_gemm(lds, obuf, wo_t + (size_t)j * 1024 * 1024, MH, 1024, 1024, E, wid); }
            PH_END
            PH_BEGIN_G(3)
            { rstd_to_lds(lds, ssq, 16, ro, MH, FF, wid);
              pg8::EpiAct E{acth, FF, ssq, 16, sw1 + (size_t)l * 16 * FF, ro, 1, 1.0f, 0, (unsigned)(unsigned long)(lds + RL_OFF)};
              run_gemm(lds, hs + (size_t)ro * DM, W1T(l), MH, FF, 1024, E, wid); }
            PH_END
            PH_BEGIN
            if (l == 2) { pg8::EpiRes E{hbuf, hbuf, hs, MODS(l, 1) + 2048, GMT(l * 2 + 2), ssq, ro, nullptr, nullptr, nullptr};
              run_gemm(lds, acth, W2T(l), MH, 1024, FF, E, wid); }
            else { pg8::EpiFinal E{hbuf, a.out, MODS(l, 1) + 2048, final_g, (float*)(ws + 512 * 1024), (unsigned*)(ws + 32768), ro, (unsigned)(unsigned long)(lds + RL_OFF)};
              run_gemm(lds, acth, W2T(l), MH, 1024, FF, E, wid); }
            PH_END
        }
    }

}
constexpr int NPHASES = 2 + 8 + 2 * (2 * 6);

extern "C" void kernel_launch(void* const* d_in, const int* in_sizes, int n_in, void* d_out, int out_size, void* d_ws, size_t ws_size, hipStream_t stream) {
    static int grid = 0;
    if (grid == 0) {
        if (n_in != 23 || out_size != MTOK * DM || ws_size < WS_NEED) { fprintf(stderr, "kernel_launch: unexpected shapes (n_in %d out %d ws %zu)\n", n_in, out_size, ws_size); grid = -1; return; }
        int dev = 0, cus = 0, per_cu = 0;
        hipGetDevice(&dev); hipDeviceGetAttribute(&cus, hipDeviceAttributeMultiprocessorCount, dev);
        hipFuncSetAttribute((const void*)fwd, hipFuncAttributeMaxDynamicSharedMemorySize, LDS_BYTES);
        hipOccupancyMaxActiveBlocksPerMultiprocessor(&per_cu, (const void*)fwd, 512, LDS_BYTES);
        (void)hipGetLastError();
        if (per_cu < 1) per_cu = 1;
        if (cus < 256) { fprintf(stderr, "kernel_launch: built for a 256-CU device (phase tilings assume 256 co-resident workgroups); found %d CUs\n", cus); grid = -1; return; }
        grid = 256;
    }
    if (grid < 0) return;
    (void)hipMemsetAsync(d_ws, 0, 65536, stream);
    Args a{};
    for (int i = 0; i < 23; ++i) a.in[i] = (const float*)d_in[i];
    a.out = (float*)d_out; a.ws = (unsigned char*)d_ws;
#if ONE_LAUNCH
    a.ph_lo = 0; a.ph_hi = NPHASES;
    void* args[] = {&a};
    hipError_t e = hipLaunchCooperativeKernel((const void*)fwd, dim3(grid), dim3(512), args, LDS_BYTES, stream);
    if (e != hipSuccess) fprintf(stderr, "cooperative launch failed: %s (grid %d)\n", hipGetErrorString(e), grid);
#else
    for (int p = 0; p < NPHASES; ++p) {
        a.ph_lo = p; a.ph_hi = p + 1;
        hipLaunchKernelGGL(fwd, dim3(grid), dim3(512), LDS_BYTES, stream, a);
    }
#endif
}
```

```cpp
#include <hip/hip_runtime.h>
#include <hip/hip_cooperative_groups.h>
#include <cstdio>
#include <cstdint>
namespace cg = cooperative_groups;

#ifndef ONE_LAUNCH
#define ONE_LAUNCH 1
#endif

#define LAS __attribute__((address_space(3)))
typedef unsigned short bf16_t;
typedef short bf16x8 __attribute__((ext_vector_type(8)));
typedef short s16x4 __attribute__((ext_vector_type(4)));
typedef float f32x4 __attribute__((ext_vector_type(4)));
typedef float f32x2 __attribute__((ext_vector_type(2)));
typedef float f32x16 __attribute__((ext_vector_type(16)));
typedef unsigned u32x4 __attribute__((ext_vector_type(4)));
typedef unsigned u32x2 __attribute__((ext_vector_type(2)));
typedef __bf16 bf16x2_t __attribute__((ext_vector_type(2)));

constexpr int DM = 1024, SEQ = 2048, NB = 16, MTOK = NB * SEQ, FF = 4096, QW = 3072, KVW = 6144;
constexpr int MH = MTOK / 2;
constexpr float EPS = 1e-6f;
constexpr float C2 = 0.125f * 1.4426950408889634f;
constexpr int SSQ_LD = 32;

constexpr size_t MiB = 1u << 20;
constexpr size_t WS_MODS = 1 * MiB;
constexpr size_t WS_KVMODS = WS_MODS + 8 * 16 * 3072 * 4;
constexpr size_t WS_GM = 3 * MiB;
constexpr size_t WS_SW1 = 4 * MiB;
constexpr size_t WS_SWQ = 5 * MiB;
constexpr size_t WS_SWKV = 5 * MiB + 512 * 1024;
constexpr size_t WS_LAMB = 6 * MiB;
constexpr size_t WS_BM = 6 * MiB + 64 * 1024;
constexpr size_t WS_CM = 6 * MiB + 64 * 1024 + 512 * 1024;
constexpr size_t WS_LSE = 8 * MiB;
constexpr size_t WS_SSQ = 12 * MiB;
constexpr size_t WS_WKV = 16 * MiB;
constexpr size_t WS_WQ = 28 * MiB;
constexpr size_t WS_WO = 40 * MiB;
constexpr size_t WS_W1B = 44 * MiB;
constexpr size_t WS_W2B = 60 * MiB;
constexpr size_t WS_WGLU = 76 * MiB;
constexpr size_t WS_W1A = 84 * MiB;
constexpr size_t WS_W2A = 100 * MiB;
constexpr size_t WS_HSKV0 = 180 * MiB;
constexpr size_t WS_HSKV1 = 76 * MiB;
constexpr size_t WS_HS = 116 * MiB;
constexpr size_t WS_R = 180 * MiB;
constexpr size_t WS_Q = WS_R + 32 * MiB;
constexpr size_t WS_O = WS_R;
constexpr size_t WS_ACTH = WS_R;
constexpr size_t WS_KVH = WS_R + 128 * MiB;
constexpr size_t WS_Z = WS_R;
constexpr size_t WS_ACTF = WS_R + 64 * MiB;
constexpr size_t WS_NEED = 500 * MiB;

constexpr int LDS_BYTES = 163840;

__device__ __forceinline__ unsigned f2bf(float f) { unsigned u = __builtin_bit_cast(unsigned, f); return (u + 0x7fffu + ((u >> 16) & 1u)) >> 16; }
__device__ __forceinline__ unsigned pk2(float lo, float hi) { f32x2 v = {lo, hi}; bf16x2_t b = __builtin_convertvector(v, bf16x2_t); return __builtin_bit_cast(unsigned, b); }
__device__ __forceinline__ float bf2f(unsigned short b) { return __builtin_bit_cast(float, (unsigned)b << 16); }
__device__ __forceinline__ float bflo(unsigned w) { return __builtin_bit_cast(float, w << 16); }
__device__ __forceinline__ float bfhi(unsigned w) { return __builtin_bit_cast(float, w & 0xffff0000u); }
__device__ __forceinline__ int crow(int r, int hi) { return (r & 3) + 8 * (r >> 2) + 4 * hi; }
template <class T> __device__ __forceinline__ T* opq(T* p) { size_t z = 0; asm volatile("" : "+s"(z)); return (T*)((char*)p + z); }
__device__ __forceinline__ int lane_id() { int l; asm volatile("v_mbcnt_lo_u32_b32 %0, -1, 0\n\tv_mbcnt_hi_u32_b32 %0, -1, %0" : "=v"(l)); return l; }
#define MFMA32(a, b, c) __builtin_amdgcn_mfma_f32_32x32x16_bf16((a), (b), (c), 0, 0, 0)
#define LDS_WAIT() asm volatile("s_waitcnt lgkmcnt(0)" ::: "memory")


__device__ __forceinline__ double exp_d(double x) {
    const double kf = __builtin_rint(x * 1.4426950408889634074);
    const double r = (x - kf * 0.693147180369123816490) - kf * 1.90821492927058770002e-10;
    double p = 1.0 / 6227020800.0;
    p = p * r + 1.0 / 479001600.0; p = p * r + 1.0 / 39916800.0; p = p * r + 1.0 / 3628800.0; p = p * r + 1.0 / 362880.0; p = p * r + 1.0 / 40320.0;
    p = p * r + 1.0 / 5040.0; p = p * r + 1.0 / 720.0; p = p * r + 1.0 / 120.0; p = p * r + 1.0 / 24.0; p = p * r + 1.0 / 6.0; p = p * r + 0.5; p = p * r + 1.0; p = p * r + 1.0;
    const long long bits = ((long long)((int)kf + 1023)) << 52;
    return p * __builtin_bit_cast(double, bits);
}
__device__ __forceinline__ void sincos_d(double x, double& sn, double& cs) {
    const double k = __builtin_rint(x * 0.15915494309189533577);
    double r = (x - k * 6.28318530717958623200) - k * 2.44929359829470635445e-16;
    const double t = r * 0.125, t2 = t * t;
    double s = -1.0 / 6227020800.0; s = s * t2 + 1.0 / 39916800.0; s = s * t2 - 1.0 / 362880.0; s = s * t2 + 1.0 / 5040.0; s = s * t2 - 1.0 / 120.0; s = s * t2 + 1.0 / 6.0; s = t - t * t2 * s;
    s = t * (1.0 + t2 * (-1.0 / 6.0 + t2 * (1.0 / 120.0 + t2 * (-1.0 / 5040.0 + t2 * (1.0 / 362880.0 + t2 * (-1.0 / 39916800.0 + t2 * (1.0 / 6227020800.0)))))));
    double c = 1.0 + t2 * (-0.5 + t2 * (1.0 / 24.0 + t2 * (-1.0 / 720.0 + t2 * (1.0 / 40320.0 + t2 * (-1.0 / 3628800.0 + t2 * (1.0 / 479001600.0 + t2 * (-1.0 / 87178291200.0)))))));
#pragma unroll
    for (int i = 0; i < 3; ++i) { const double s2 = 2.0 * s * c, c2 = 1.0 - 2.0 * s * s; s = s2; c = c2; }
    sn = s; cs = c;
}

namespace pg8 {
constexpr int BM = 256, BK = 64, HALF = 128, HTB = HALF * BK * 2, STAGE_BYTES = 8 * HTB, NXCD = 8, WGM = 4;
__host__ __device__ __forceinline__ int lds_byte(int r, int c) { const int st = (r >> 4) * 2 + (c >> 5), rr = r & 15, cc = c & 31, ob = rr * 64 + cc * 2; return st * 1024 + (ob ^ (((ob >> 9) & 1) << 5)); }
__host__ __device__ __forceinline__ void stage_rc(int b, int& R, int& C) { const int st = b / 1024, sb = b % 1024, swz = sb ^ (((sb >> 9) & 1) << 5); R = (st >> 1) * 16 + swz / 64; C = (st & 1) * 32 + (swz % 64) / 2; }
__host__ __device__ __forceinline__ int perm32(int rho) { const int n = rho >> 4, i = rho & 15; return 8 * (i >> 2) + 4 * n + (i & 3); }
struct Unit { int pm, pn; };
struct Gemm { const bf16_t* A; const bf16_t* Bt; int M, N, K; };
struct StaticOrder {
    int nM, nN, nwg, G, c;
    __host__ __device__ void init(int M, int N, int G_, int c_) { nM = M / BM; nN = N / BM; nwg = nM * nN; G = G_; c = c_; }
    __host__ __device__ bool next(int i, Unit& u) const {
        const long L = (long)i * G + c; if (L >= nwg) return false;
        int wgid = (int)L; { const int q = nwg / NXCD, r = nwg % NXCD, xcd = wgid % NXCD, off = wgid / NXCD; wgid = (xcd < r ? xcd * (q + 1) : r * (q + 1) + (xcd - r) * q) + off; }
        const int nig = WGM * nN, gid = wgid / nig, fm = gid * WGM, gsz = (nM - fm) < WGM ? (nM - fm) : WGM;
        u.pm = fm + ((wgid % nig) % gsz); u.pn = (wgid % nig) / gsz; return true;
    }
    __device__ __forceinline__ void a_ready(const Unit&) const {}
    __device__ __forceinline__ void done(const Unit&) const {}
};

__device__ __forceinline__ float row_rstd(const float* ssq, size_t grow, int nslots) {
    const f32x4* p = (const f32x4*)(ssq + grow * SSQ_LD);
    f32x4 a = p[0] + p[1] + p[2] + p[3];
    if (nslots > 16) a = a + p[4] + p[5] + p[6] + p[7];
    const float s = (a[0] + a[1]) + (a[2] + a[3]);
    return __builtin_amdgcn_rsqf(s * (1.0f / DM) + EPS);
}

__device__ __forceinline__ float row_rstd4(const float* ssq, size_t grow, int nslots, int fq) {
    const f32x4* p = (const f32x4*)(ssq + grow * SSQ_LD);
    f32x4 a = p[fq];
    if (nslots > 16) a = a + p[4 + fq];
    float s = (a[0] + a[1]) + (a[2] + a[3]);
    s += __shfl_xor(s, 16); s += __shfl_xor(s, 32);
    return __builtin_amdgcn_rsqf(s * (1.0f / DM) + EPS);
}
__device__ __forceinline__ int perm_pos(int br, int pos) { return br == 0 ? pos : (br == 1 ? ((pos & 3) * 512 + (pos >> 2)) : ((pos & 15) * 128 + (pos >> 4))); }
template <int ACT, bool SCALED, bool HM> struct EpiActT {
    static constexpr bool PERM = true;
    static constexpr int act = ACT; static constexpr bool hm = HM;
    bf16_t* O; int ldc; const float* ssq; int nslots; const float* sw; int row_off; float scale;
    unsigned rl_addr;
    __device__ __forceinline__ void operator()(const f32x4 (&acc)[2][2][4][2], const Unit& u, int wr, int wc, int fr, int fq, int ui) const {
#ifdef NO_ACT
        if (row_off >= 0) return;
#endif
        bf16_t* const O = opq(this->O); const float* const ssq = opq(this->ssq); const float* const sw = opq(this->sw);
        const int row0 = u.pm * BM + wr * 64 + fr; const int b = (row_off + u.pm * BM) >> 11;
        const int col0 = u.pn * BM + wc * 32 + 8 * fq;
        f32x4 bv[2][2];
#pragma unroll
        for (int bj = 0; bj < 2; ++bj)
#pragma unroll
            for (int n = 0; n < 2; ++n) bv[bj][n] = *(const f32x4*)(sw + (size_t)b * ldc + col0 + bj * HALF + 4 * n);
#pragma unroll
        for (int ai = 0; ai < 2; ++ai)
#pragma unroll
            for (int m = 0; m < 4; ++m) {
                const int lrow = row0 + ai * HALF + m * 16;
                const float rs = *(const LAS float*)(unsigned long)(rl_addr + 4u * (unsigned)(ui * BM + (lrow - u.pm * BM)));
                bf16_t* rowp = O + (size_t)lrow * ldc + col0;
                if (hm) { const int br = ((u.pn * BM) >> 10) % 3; rowp = O + ((size_t)(col0 >> 6) * MH + (lrow & ~2047) + perm_pos(br, lrow & 2047)) * 64 + (col0 & 63); }
#pragma unroll
                for (int bj = 0; bj < 2; ++bj) {
                    f32x4 v0 = acc[ai][bj][m][0] * rs + bv[bj][0], v1 = acc[ai][bj][m][1] * rs + bv[bj][1];
                    if (act == 1) {
#pragma unroll
                        for (int j = 0; j < 4; ++j) { float x = fmaxf(v0[j], 0.f); v0[j] = x * x; float y = fmaxf(v1[j], 0.f); v1[j] = y * y; }
                    }
                    if (SCALED) { v0 = v0 * scale; v1 = v1 * scale; }
                    u32x4 w; w.x = pk2(v0[0], v0[1]); w.y = pk2(v0[2], v0[3]); w.z = pk2(v1[0], v1[1]); w.w = pk2(v1[2], v1[3]);
                    *(u32x4*)(rowp + (hm ? bj * 2 * MH * 64 : bj * HALF)) = w;
                }
                asm volatile("" ::: "memory");
            }
    }
};

constexpr int HLD = 2048;
__device__ __forceinline__ f32x4 ld_h4(const bf16_t* p) { const u32x2 w = *(const u32x2*)p; return (f32x4){bflo(w.x), bfhi(w.x), bflo(w.y), bfhi(w.y)}; }
__device__ __forceinline__ void st_h4(bf16_t* p, const f32x4 v) { u32x2 w; w.x = pk2(v[0], v[1]); w.y = pk2(v[2], v[3]); *(u32x2*)p = w; }
__device__ __forceinline__ void ld_h8(const bf16_t* p, f32x4& a, f32x4& b) { const u32x4 w = *(const u32x4*)p; a = (f32x4){bflo(w.x), bfhi(w.x), bflo(w.y), bfhi(w.y)}; b = (f32x4){bflo(w.z), bfhi(w.z), bflo(w.w), bfhi(w.w)}; }
__device__ __forceinline__ void st_h8(bf16_t* p, const f32x4 a, const f32x4 b) { u32x4 w; w.x = pk2(a[0], a[1]); w.y = pk2(a[2], a[3]); w.z = pk2(b[0], b[1]); w.w = pk2(b[2], b[3]); *(u32x4*)p = w; }
struct EpiRes {
    static constexpr bool PERM = true;
    const bf16_t* res; bf16_t* hout; bf16_t* hs; const float* gate; const float* gm; float* ssq; int row_off;
    bf16_t* hs2a; bf16_t* hs2b; const float* gm2;
    __device__ __forceinline__ void operator()(const f32x4 (&acc)[2][2][4][2], const Unit& u, int wr, int wc, int fr, int fq, int ui) const {
#ifdef NO_RES
        if (row_off >= 0) return;
#endif
        const bf16_t* const res = opq(this->res); bf16_t* const hout = opq(this->hout); bf16_t* const hs = opq(this->hs); const float* const gate = opq(this->gate); const float* const gm = opq(this->gm); float* const ssq = opq(this->ssq);
        const int b = (row_off + u.pm * BM) >> 11;
        const int col0 = u.pn * BM + wc * 32 + 8 * fq;
        const float* gp = gate + (size_t)b * 3072 + col0; const float* mp = gm + (size_t)b * DM + col0;
        const bool two = gm2 != nullptr;
        const float* mp2 = two ? opq(gm2) + (size_t)b * DM + col0 : mp;
        bf16_t* h2 = (row_off + u.pm * BM >= MH) ? opq(hs2b) - (size_t)MH * DM : opq(hs2a);
        float ssv[2][4];
#pragma unroll
        for (int ai = 0; ai < 2; ++ai)
#pragma unroll
            for (int m = 0; m < 4; ++m) ssv[ai][m] = 0.f;
#pragma unroll
        for (int bj = 0; bj < 2; ++bj) {
            const int co = bj * HALF;
            const f32x4 gv0 = *(const f32x4*)(gp + co), gv1 = *(const f32x4*)(gp + co + 4), mv0 = *(const f32x4*)(mp + co), mv1 = *(const f32x4*)(mp + co + 4);
#pragma unroll
            for (int ai = 0; ai < 2; ++ai)
#pragma unroll
                for (int m = 0; m < 4; ++m) {
                    const size_t grow = (size_t)(row_off + u.pm * BM + ai * HALF + wr * 64 + m * 16 + fr);
                    f32x4 r0, r1; ld_h8(res + grow * HLD + col0 + co, r0, r1);
                    const f32x4 hn0 = r0 + gv0 * acc[ai][bj][m][0], hn1 = r1 + gv1 * acc[ai][bj][m][1];
                    st_h8(hout + grow * HLD + col0 + co, hn0, hn1);
                    ssv[ai][m] += ((hn0[0] * hn0[0] + hn0[1] * hn0[1]) + (hn0[2] * hn0[2] + hn0[3] * hn0[3])) + ((hn1[0] * hn1[0] + hn1[1] * hn1[1]) + (hn1[2] * hn1[2] + hn1[3] * hn1[3]));
                    st_h8(hs + grow * DM + col0 + co, hn0 * mv0, hn1 * mv1);
                    if (two) { const f32x4 m20 = *(const f32x4*)(mp2 + co), m21 = *(const f32x4*)(mp2 + co + 4); st_h8(h2 + grow * DM + col0 + co, hn0 * m20, hn1 * m21); }
                    asm volatile("" ::: "memory");
                }
        }
#pragma unroll
        for (int ai = 0; ai < 2; ++ai)
#pragma unroll
            for (int m = 0; m < 4; ++m) {
                const size_t grow = (size_t)(row_off + u.pm * BM + ai * HALF + wr * 64 + m * 16 + fr);
                float ss = ssv[ai][m];
                ss += __shfl_xor(ss, 16); ss += __shfl_xor(ss, 32);
                if (fq == 0) ssq[grow * SSQ_LD + u.pn * 4 + wc] = ss;
            }
    }
};

struct EpiGlu {
    static constexpr bool PERM = true;
    const void* res; int res_f32; bf16_t* hout; bf16_t* hs; const float* gate; const float* gm; float* ssq; int row_off;
    __device__ __forceinline__ void operator()(const f32x4 (&acc)[2][2][4][2], const Unit& u, int wr, int wc, int fr, int fq, int ui) const {
#ifdef NO_GLU
        if (row_off >= 0) return;
#endif
        const void* const res = opq(this->res); bf16_t* const hout = opq(this->hout); bf16_t* const hs = opq(this->hs); const float* const gate = opq(this->gate); const float* const gm = opq(this->gm); float* const ssq = opq(this->ssq);
        const int b = (row_off + u.pm * BM) >> 11;
        const int col0 = u.pn * HALF + wc * 32 + 8 * fq;
        const float* gp = gate + (size_t)b * 3072 + col0; const float* mp = gm + (size_t)b * DM + col0;
        const f32x4 gv0 = *(const f32x4*)(gp), gv1 = *(const f32x4*)(gp + 4), mv0 = *(const f32x4*)(mp), mv1 = *(const f32x4*)(mp + 4);
#pragma unroll
        for (int ai = 0; ai < 2; ++ai)
#pragma unroll
            for (int m = 0; m < 4; ++m) {
                const size_t grow = (size_t)(row_off + u.pm * BM + ai * HALF + wr * 64 + m * 16 + fr);
                f32x4 r0, r1;
                if (res_f32) { r0 = *(const f32x4*)((const float*)res + grow * DM + col0); r1 = *(const f32x4*)((const float*)res + grow * DM + col0 + 4); }
                else ld_h8((const bf16_t*)res + grow * HLD + col0, r0, r1);
                f32x4 hn0, hn1;
#pragma unroll
                for (int j = 0; j < 4; ++j) {
                    const float s0 = __builtin_amdgcn_rcpf(1.0f + __expf(-acc[ai][1][m][0][j])), s1 = __builtin_amdgcn_rcpf(1.0f + __expf(-acc[ai][1][m][1][j]));
                    hn0[j] = r0[j] + gv0[j] * (acc[ai][0][m][0][j] * s0); hn1[j] = r1[j] + gv1[j] * (acc[ai][0][m][1][j] * s1); }
                st_h8(hout + grow * HLD + col0, hn0, hn1);
                float ss = ((hn0[0] * hn0[0] + hn0[1] * hn0[1]) + (hn0[2] * hn0[2] + hn0[3] * hn0[3])) + ((hn1[0] * hn1[0] + hn1[1] * hn1[1]) + (hn1[2] * hn1[2] + hn1[3] * hn1[3]));
                st_h8(hs + grow * DM + col0, hn0 * mv0, hn1 * mv1);
                ss += __shfl_xor(ss, 16); ss += __shfl_xor(ss, 32);
                if (fq == 0) ssq[grow * SSQ_LD + u.pn * 4 + wc] = ss;
                asm volatile("" ::: "memory");
            }
    }
};

struct EpiFinal {
    static constexpr bool PERM = true;
    const bf16_t* res; float* out; const float* gate; const float* fg; float* xbuf; unsigned* cnt; int row_off; unsigned lds_addr;
    __device__ __forceinline__ void operator()(f32x4 (&acc)[2][2][4][2], const Unit& u, int wr, int wc, int fr, int fq, int ui) const {
        const bf16_t* const res = opq(this->res); float* const out = opq(this->out); const float* const gate = opq(this->gate); const float* const fg = opq(this->fg);
        const int b = (row_off + u.pm * BM) >> 11;
        const int col0 = u.pn * BM + wc * 32 + 8 * fq;
        const float* gp = gate + (size_t)b * 3072 + col0;
        LAS float* P = (LAS float*)(unsigned long)lds_addr;
        LAS float* R = (LAS float*)(unsigned long)(lds_addr + 4096);
        LAS unsigned* flag = (LAS unsigned*)(unsigned long)(lds_addr + 4096 + 1024);
        const int lane = fq * 16 + fr, wid = wr * 4 + wc;
        float ssv[2][4];
#pragma unroll
        for (int ai = 0; ai < 2; ++ai)
#pragma unroll
            for (int m = 0; m < 4; ++m) ssv[ai][m] = 0.f;
#pragma unroll
        for (int bj = 0; bj < 2; ++bj) {
            const int co = bj * HALF;
            const f32x4 gv0 = *(const f32x4*)(gp + co), gv1 = *(const f32x4*)(gp + co + 4);
#pragma unroll
            for (int ai = 0; ai < 2; ++ai)
#pragma unroll
                for (int m = 0; m < 4; ++m) {
                    const size_t grow = (size_t)(row_off + u.pm * BM + ai * HALF + wr * 64 + m * 16 + fr);
                    f32x4 r0, r1; ld_h8(res + grow * HLD + col0 + co, r0, r1);
                    const f32x4 hn0 = r0 + gv0 * acc[ai][bj][m][0], hn1 = r1 + gv1 * acc[ai][bj][m][1];
                    acc[ai][bj][m][0] = hn0; acc[ai][bj][m][1] = hn1;
                    ssv[ai][m] += ((hn0[0] * hn0[0] + hn0[1] * hn0[1]) + (hn0[2] * hn0[2] + hn0[3] * hn0[3])) + ((hn1[0] * hn1[0] + hn1[1] * hn1[1]) + (hn1[2] * hn1[2] + hn1[3] * hn1[3]));
                }
        }
#pragma unroll
        for (int ai = 0; ai < 2; ++ai)
#pragma unroll
            for (int m = 0; m < 4; ++m) {
                const int trow = ai * HALF + wr * 64 + m * 16 + fr;
                float ss = ssv[ai][m];
                ss += __shfl_xor(ss, 16); ss += __shfl_xor(ss, 32);
                if (fq == 0) P[trow * 4 + wc] = ss;
            }
        asm volatile("s_waitcnt lgkmcnt(0)" ::: "memory"); __builtin_amdgcn_s_barrier(); asm volatile("" ::: "memory");
        const int row = wid * 32 + (lane & 31);
        if (lane < 32) {
            const float t = (P[row * 4 + 0] + P[row * 4 + 1]) + (P[row * 4 + 2] + P[row * 4 + 3]);
            __hip_atomic_store(xbuf + ((size_t)(row_off + u.pm * BM + row) * 4 + u.pn), t, __ATOMIC_RELAXED, __HIP_MEMORY_SCOPE_AGENT);
        }
        asm volatile("s_waitcnt vmcnt(0)" ::: "memory");
        unsigned* cw = cnt + 64 * ((row_off >> 8) + u.pm);
        if (lane == 0) __hip_atomic_fetch_add(cw, 1u, __ATOMIC_RELAXED, __HIP_MEMORY_SCOPE_AGENT);
        if (wid == 0) {
            unsigned sp = 0; bool dead = false;
            for (;;) {
                if ((unsigned)__builtin_amdgcn_readfirstlane(__hip_atomic_load(cw, __ATOMIC_RELAXED, __HIP_MEMORY_SCOPE_AGENT)) >= 32u) break;
                __builtin_amdgcn_s_sleep(2);
                if (++sp > (1u << 22)) { dead = true; break; }
            }
            __builtin_amdgcn_fence(__ATOMIC_ACQUIRE, "agent");
            if (lane == 0) flag[0] = dead ? 1u : 0u;
        }
        asm volatile("s_waitcnt vmcnt(0) lgkmcnt(0)" ::: "memory"); __builtin_amdgcn_s_barrier(); asm volatile("" ::: "memory");
        if (lane < 32) {
            const float* slot = xbuf + (size_t)(row_off + u.pm * BM + row) * 4;
            float t = 0.f;
#pragma unroll
            for (int q = 0; q < 4; ++q) t += __hip_atomic_load(slot + q, __ATOMIC_RELAXED, __HIP_MEMORY_SCOPE_AGENT);
            R[row] = __builtin_amdgcn_rsqf(t * (1.0f / DM) + EPS);
        }
        asm volatile("s_waitcnt vmcnt(0) lgkmcnt(0)" ::: "memory"); __builtin_amdgcn_s_barrier(); asm volatile("" ::: "memory");
        const bool bad = flag[0] != 0u;
        const float qn = __builtin_nanf("");
        f32x4 fv[2][2];
#pragma unroll
        for (int bj = 0; bj < 2; ++bj)
#pragma unroll
            for (int n = 0; n < 2; ++n) fv[bj][n] = *(const f32x4*)(fg + col0 + bj * HALF + 4 * n);
#pragma unroll
        for (int ai = 0; ai < 2; ++ai)
#pragma unroll
            for (int m = 0; m < 4; ++m) {
                const int trow = ai * HALF + wr * 64 + m * 16 + fr;
                const size_t grow = (size_t)(row_off + u.pm * BM + trow);
                const float rs = bad ? qn : R[trow];
#pragma unroll
                for (int bj = 0; bj < 2; ++bj)
#pragma unroll
                    for (int n = 0; n < 2; ++n) *(f32x4*)(out + grow * DM + col0 + bj * HALF + 4 * n) = acc[ai][bj][m][n] * rs * fv[bj][n];
                asm volatile("" ::: "memory");
            }
    }
};

template <class Epi, class Sched, bool ALIGN_EPI = false, bool SP2 = false>
__device__ __forceinline__ void gemm_phase(LAS unsigned char* lds, const Gemm g, const Sched& S, const Epi& E, const int wid) {
    const int lane = lane_id(), tid = wid * 64 + lane, wr = wid >> 2, wc = wid & 3, fr = lane & 15, fq = lane >> 4;
    const int K = g.K, nt = K / BK;
    unsigned voffA[2], voffB[2];
#pragma unroll
    for (int i = 0; i < 2; ++i) { int R, C; stage_rc(tid * 16 + i * 8192, R, C); const int Rb = Epi::PERM ? ((R & ~31) + perm32(R & 31)) : R;
        voffA[i] = (unsigned)(R * K + C) * 2u; voffB[i] = (unsigned)(Rb * K + C) * 2u; }
    const size_t kstep = (size_t)(BK * 2);
    const size_t hstep = (size_t)HALF * K * 2;
    const size_t tstep = 2 * hstep;
    const unsigned ldsw = (unsigned)wid * 1024u;
    const int aoff = lds_byte(wr * 64 + fr, fq * 8), boff = lds_byte(wc * 32 + fr, fq * 8);
#define PG8_SA(b, h) (((b) * 2 + (h)) * HTB)
#define PG8_SB(b, h) ((4 + (b) * 2 + (h)) * HTB)
#define PG8_STAGE(bufoff, gbase, voff) do { _Pragma("unroll") for (int _i = 0; _i < 2; ++_i) \
        __builtin_amdgcn_global_load_lds((const unsigned*)((const char*)(gbase) + (voff)[_i]), (LAS unsigned*)(lds + (bufoff) + ldsw + _i * 8192), 16, 0, 0); } while (0)
#define PG8_LDA(dst, b, h) do { _Pragma("unroll") for (int m = 0; m < 4; ++m) _Pragma("unroll") for (int k = 0; k < 2; ++k) dst[m][k] = *(const LAS bf16x8*)(lds + PG8_SA(b, h) + aoff + m * 2048 + k * 1024); } while (0)
#define PG8_LDB(dst, b, h) do { _Pragma("unroll") for (int n = 0; n < 2; ++n) _Pragma("unroll") for (int k = 0; k < 2; ++k) dst[n][k] = *(const LAS bf16x8*)(lds + PG8_SB(b, h) + boff + n * 2048 + k * 1024); } while (0)
#define PG8_MMA(ai, bj, At, Bt) do { __builtin_amdgcn_s_setprio(1); _Pragma("unroll") for (int m = 0; m < 4; ++m) _Pragma("unroll") for (int n = 0; n < 2; ++n) _Pragma("unroll") for (int k = 0; k < 2; ++k) \
        acc[ai][bj][m][n] = __builtin_amdgcn_mfma_f32_16x16x32_bf16(Bt[n][k], At[m][k], acc[ai][bj][m][n], 0, 0, 0); __builtin_amdgcn_s_setprio(0); } while (0)
#define PG8_WAIT_V(n) asm volatile("s_waitcnt vmcnt(" #n ")" ::: "memory")
#define PG8_WAIT_L(n) asm volatile("s_waitcnt lgkmcnt(" #n ")" ::: "memory")
#define PG8_BAR __builtin_amdgcn_s_barrier()
#define PG8_SCHED __builtin_amdgcn_sched_barrier(0)
    Unit cur, nxt; int ui = 0;
    (void)S.next(0, cur);
    f32x4 acc[2][2][4][2];
#pragma unroll
    for (int a = 0; a < 2; ++a)
#pragma unroll
        for (int b = 0; b < 2; ++b)
#pragma unroll
            for (int m = 0; m < 4; ++m)
#pragma unroll
                for (int n = 0; n < 2; ++n) acc[a][b][m][n] = (f32x4){0.f, 0.f, 0.f, 0.f};
    bf16x8 At[4][2], B0[2][2], B1[2][2];
    const char* cA = (const char*)g.A + (size_t)cur.pm * tstep; const char* cB = (const char*)g.Bt + (size_t)cur.pn * tstep;
    S.a_ready(cur);
    if constexpr (SP2) {
        PG8_STAGE(PG8_SB(0, 0), cB, voffB); PG8_STAGE(PG8_SB(0, 1), cB + hstep, voffB); PG8_STAGE(PG8_SA(0, 0), cA, voffA); PG8_STAGE(PG8_SA(0, 1), cA + hstep, voffA);
        if (wr == 1) PG8_BAR;
        PG8_WAIT_V(2); PG8_BAR;
        PG8_STAGE(PG8_SB(1, 0), cB + kstep, voffB); PG8_STAGE(PG8_SA(1, 0), cA + kstep, voffA); PG8_STAGE(PG8_SB(1, 1), cB + hstep + kstep, voffB);
        PG8_WAIT_V(6); PG8_BAR;
    } else {
        PG8_STAGE(PG8_SB(0, 0), cB, voffB); PG8_STAGE(PG8_SA(0, 0), cA, voffA); PG8_STAGE(PG8_SB(0, 1), cB + hstep, voffB); PG8_STAGE(PG8_SA(0, 1), cA + hstep, voffA);
        if (wr == 1) PG8_BAR;
        PG8_WAIT_V(4); PG8_BAR;
        PG8_STAGE(PG8_SB(1, 0), cB + kstep, voffB); PG8_STAGE(PG8_SA(1, 0), cA + kstep, voffA); PG8_STAGE(PG8_SB(1, 1), cB + hstep + kstep, voffB);
        PG8_WAIT_V(6); PG8_BAR;
    }
    for (;;) {
        const bool has_next = S.next(ui + 1, nxt);
        const char* nA = has_next ? (const char*)g.A + (size_t)nxt.pm * tstep : cA; const char* nB = has_next ? (const char*)g.Bt + (size_t)nxt.pn * tstep : cB;
        for (int t = 0; t < nt; t += 2) {
            const bool last = (t == nt - 2);
            const char* a1 = cA + (size_t)(t + 1) * kstep;
            const char* a2 = last ? nA : cA + (size_t)(t + 2) * kstep; const char* b2 = last ? nB : cB + (size_t)(t + 2) * kstep;
            const char* a3 = a2 + kstep; const char* b3 = b2 + kstep;
            if (last && has_next) S.a_ready(nxt);
            if constexpr (SP2) {
            PG8_LDB(B0, 0, 0); PG8_LDB(B1, 0, 1); PG8_SCHED; PG8_LDA(At, 0, 0); PG8_STAGE(PG8_SA(1, 1), a1 + hstep, voffA);
            PG8_WAIT_V(8); PG8_WAIT_L(0); PG8_BAR; PG8_MMA(0, 0, At, B0); PG8_MMA(0, 1, At, B1); PG8_BAR; PG8_SCHED;
            PG8_LDA(At, 0, 1); PG8_STAGE(PG8_SB(0, 0), b2, voffB); PG8_STAGE(PG8_SB(0, 1), b2 + hstep, voffB); PG8_STAGE(PG8_SA(0, 0), a2, voffA);
            PG8_WAIT_V(8); PG8_WAIT_L(0); PG8_BAR; PG8_MMA(1, 0, At, B0); PG8_MMA(1, 1, At, B1); PG8_BAR; PG8_SCHED;
            PG8_LDB(B0, 1, 0); PG8_LDB(B1, 1, 1); PG8_SCHED; PG8_LDA(At, 1, 0); PG8_STAGE(PG8_SA(0, 1), a2 + hstep, voffA);
            PG8_WAIT_V(8); PG8_WAIT_L(0); PG8_BAR; PG8_MMA(0, 0, At, B0); PG8_MMA(0, 1, At, B1); PG8_BAR; PG8_SCHED;
            PG8_LDA(At, 1, 1); PG8_STAGE(PG8_SB(1, 0), b3, voffB); PG8_STAGE(PG8_SB(1, 1), b3 + hstep, voffB); PG8_STAGE(PG8_SA(1, 0), a3, voffA);
            PG8_WAIT_V(8); PG8_WAIT_L(0); PG8_BAR; PG8_MMA(1, 0, At, B0); PG8_MMA(1, 1, At, B1); PG8_BAR; PG8_SCHED;
            } else {
            PG8_LDB(B0, 0, 0); PG8_SCHED; PG8_LDA(At, 0, 0); PG8_STAGE(PG8_SA(1, 1), a1 + hstep, voffA);
            PG8_WAIT_L(8); PG8_BAR; PG8_WAIT_L(0); PG8_MMA(0, 0, At, B0); PG8_BAR; PG8_SCHED;
            PG8_LDB(B1, 0, 1); PG8_STAGE(PG8_SB(0, 0), b2, voffB);
            PG8_BAR; PG8_WAIT_L(0); PG8_MMA(0, 1, At, B1); PG8_BAR;
            PG8_LDA(At, 0, 1); PG8_STAGE(PG8_SA(0, 0), a2, voffA);
            PG8_BAR; PG8_WAIT_L(0); PG8_MMA(1, 0, At, B0); PG8_BAR; PG8_SCHED;
            PG8_STAGE(PG8_SB(0, 1), b2 + hstep, voffB);
            PG8_WAIT_V(6); PG8_BAR; PG8_MMA(1, 1, At, B1); PG8_BAR;
            PG8_LDB(B0, 1, 0); PG8_SCHED; PG8_LDA(At, 1, 0); PG8_STAGE(PG8_SA(0, 1), a2 + hstep, voffA);
            PG8_WAIT_L(8); PG8_BAR; PG8_WAIT_L(0); PG8_MMA(0, 0, At, B0); PG8_BAR; PG8_SCHED;
            PG8_LDB(B1, 1, 1); PG8_STAGE(PG8_SB(1, 0), b3, voffB);
            PG8_BAR; PG8_WAIT_L(0); PG8_MMA(0, 1, At, B1); PG8_BAR;
            PG8_LDA(At, 1, 1); PG8_STAGE(PG8_SA(1, 0), a3, voffA);
            PG8_BAR; PG8_WAIT_L(0); PG8_MMA(1, 0, At, B0); PG8_BAR; PG8_SCHED;
            PG8_STAGE(PG8_SB(1, 1), b3 + hstep, voffB);
            PG8_WAIT_V(6); PG8_BAR; PG8_MMA(1, 1, At, B1); PG8_BAR;
            }
        }
        if constexpr (ALIGN_EPI) { if (wr == 0) PG8_BAR; }
        E(acc, cur, wr, wc, fr, fq, ui); S.done(cur);
        if (!has_next) break;
#pragma unroll
        for (int a = 0; a < 2; ++a)
#pragma unroll
            for (int b = 0; b < 2; ++b)
#pragma unroll
                for (int m = 0; m < 4; ++m)
#pragma unroll
                    for (int n = 0; n < 2; ++n) acc[a][b][m][n] = (f32x4){0.f, 0.f, 0.f, 0.f};
        cur = nxt; cA = nA; cB = nB; ++ui;
        if constexpr (ALIGN_EPI) { if (wr == 1) PG8_BAR; }
    }
    PG8_WAIT_V(0);
    if constexpr (!ALIGN_EPI) { if (wr == 0) PG8_BAR; }
    PG8_BAR;
#undef PG8_SA
#undef PG8_SB
#undef PG8_STAGE
#undef PG8_LDA
#undef PG8_LDB
#undef PG8_MMA
#undef PG8_WAIT_V
#undef PG8_WAIT_L
#undef PG8_BAR
#undef PG8_SCHED
}
}

template <class Epi>
__device__ __forceinline__ void run_gemm(LAS unsigned char* lds, const bf16_t* A, const bf16_t* Bt, int M, int N, int K, const Epi& E, const int wid) {
    pg8::Gemm g{opq(A), opq(Bt), M, N, K}; pg8::StaticOrder S; S.init(M, N, (int)gridDim.x, (int)blockIdx.x);
    int w_ = wid; asm volatile("" : "+s"(w_));
    pg8::gemm_phase<Epi, pg8::StaticOrder, true, true>(lds, g, S, E, w_);
}

constexpr int RL_OFF = 131072;
__device__ __forceinline__ void rstd_to_lds(LAS unsigned char* lds, const float* ssq, int nslots, int row_off, int M, int N, const int wid) {
    LAS float* rl = (LAS float*)(lds + RL_OFF);
    pg8::StaticOrder S; S.init(M, N, (int)gridDim.x, (int)blockIdx.x); pg8::Unit u;
    const int tid = wid * 64 + lane_id(), hf = tid >> 8, row = tid & 255;
    ssq = opq(ssq);
    for (int i = hf; ; i += 8) {
        pg8::Unit u1, u2, u3;
        const bool v0 = S.next(i, u), v1 = S.next(i + 2, u1), v2 = S.next(i + 4, u2), v3 = S.next(i + 6, u3);
        if (!v0) break;
        const float r0 = pg8::row_rstd(ssq, (size_t)(row_off + u.pm * 256 + row), nslots);
        const float r1 = v1 ? pg8::row_rstd(ssq, (size_t)(row_off + u1.pm * 256 + row), nslots) : 0.f;
        const float r2 = v2 ? pg8::row_rstd(ssq, (size_t)(row_off + u2.pm * 256 + row), nslots) : 0.f;
        const float r3 = v3 ? pg8::row_rstd(ssq, (size_t)(row_off + u3.pm * 256 + row), nslots) : 0.f;
        rl[i * 256 + row] = r0;
        if (v1) rl[(i + 2) * 256 + row] = r1;
        if (v2) rl[(i + 4) * 256 + row] = r2;
        if (v3) rl[(i + 6) * 256 + row] = r3;
    }
    __syncthreads();
}
__device__ __forceinline__ void transpose_item(const float* W, int K, int N, bf16_t* WT, int mode, LAS float* scr, int item, int lane) {
    const int nblk = N / 32, kb = item / nblk, nb = item % nblk, k0 = 64 * kb, n0 = 32 * nb;
    float tv[32];
#pragma unroll
    for (int i = 0; i < 32; ++i) { const int kk = 2 * i + (lane >> 5); tv[i] = W[(size_t)(k0 + kk) * N + n0 + (lane & 31)]; }
#pragma unroll
    for (int i = 0; i < 32; ++i) { const int kk = 2 * i + (lane >> 5); scr[kk * 33 + (lane & 31)] = tv[i]; }
    LDS_WAIT();
    int d0 = n0;
    if (mode == 1) { const int bj = n0 >> 10, rem = n0 & 1023; d0 = 256 * (rem >> 7) + 128 * bj + (rem & 127); }
    const int c = lane & 7;
#pragma unroll
    for (int j = 0; j < 4; ++j) { const int n = (lane >> 3) + 8 * j; const LAS float* s = scr + (8 * c) * 33 + n;
        u32x4 o; o.x = pk2(s[0 * 33], s[1 * 33]); o.y = pk2(s[2 * 33], s[3 * 33]); o.z = pk2(s[4 * 33], s[5 * 33]); o.w = pk2(s[6 * 33], s[7 * 33]);
        *(u32x4*)(WT + (size_t)(d0 + n) * K + k0 + 8 * c) = o; }
    LDS_WAIT();
}

__device__ __forceinline__ void gemv_load_vec(LAS float* vs, const float* vin, int ldin, bool do_silu, const int wid) {
    __syncthreads();
    for (int i = wid * 64 + lane_id(); i < 16 * 1024; i += 512) { const int b = i >> 10, k = i & 1023; float v = vin[(size_t)b * ldin + k]; if (do_silu) v = v / (1.0f + __expf(-v)); vs[k * 16 + b] = v; }
    __syncthreads();
}
__device__ __forceinline__ void gemv_item(LAS float* vs, LAS float* red, const float* W, int N, const float* bias, float* out, int cg0, const int wid) {
    const int lane = lane_id(), tid = wid * 64 + lane;
    float acc[16];
#pragma unroll
    for (int b = 0; b < 16; ++b) acc[b] = 0.f;
    const float* wp = W + (size_t)(wid * 128) * N + cg0 + lane;
    for (int k0 = 0; k0 < 128; k0 += 32) {
        float wv[32];
#pragma unroll
        for (int k = 0; k < 32; ++k) wv[k] = wp[(size_t)(k0 + k) * N];
#pragma unroll
        for (int k = 0; k < 32; ++k) {
            const LAS f32x4* v = (const LAS f32x4*)(vs + (wid * 128 + k0 + k) * 16);
#pragma unroll
            for (int q = 0; q < 4; ++q) { const f32x4 x = v[q];
#pragma unroll
                for (int j = 0; j < 4; ++j) acc[4 * q + j] += x[j] * wv[k]; }
        }
    }
#pragma unroll
    for (int b = 0; b < 16; ++b) red[(wid * 16 + b) * 64 + lane] = acc[b];
    __syncthreads();
    for (int o = tid; o < 1024; o += 512) { const int b = o >> 6, c = o & 63; float s = 0.f;
#pragma unroll
        for (int w = 0; w < 8; ++w) s += red[(w * 16 + b) * 64 + c];
        out[(size_t)b * N + cg0 + c] = s + (bias ? bias[cg0 + c] : 0.f); }
    __syncthreads();
}

__device__ __forceinline__ float wave_sum(float v) {
#pragma unroll
    for (int o = 1; o < 64; o <<= 1) v += __shfl_xor(v, o);
    return v;
}

__device__ __forceinline__ void s5_phase(LAS unsigned char* lds, const bf16_t* hs, const float* ssq, const float* shift, const float* lamb, const bf16_t* Bm, const bf16_t* Cm,
                                         const float* dskip, bf16_t* z, const int wid) {
    const int lane = lane_id(), r32 = lane & 31, hi = lane >> 5, l15 = lane & 15, quad = lane >> 4;
    if (wid >= 4) return;
    hs = opq(hs); ssq = opq(ssq); shift = opq(shift); lamb = opq(lamb); Bm = opq(Bm); Cm = opq(Cm); dskip = opq(dskip); z = opq(z);
    LAS float* BUt = (LAS float*)(lds + wid * 30208);
    LAS bf16_t* Ss = (LAS bf16_t*)(lds + wid * 30208 + 18432);
    LAS float* Us = (LAS float*)(lds + wid * 30208 + 18432 + 8704);
    LAS bf16_t* Zt = (LAS bf16_t*)(lds + wid * 30208 + 18432 + 8704 + 2048);
    for (int unit = (int)blockIdx.x * 4 + wid; unit < NB * 64; unit += (int)gridDim.x * 4) {
        const int b = unit >> 6, g = unit & 63;
        bf16x8 Bf[4], Cf[4];
#pragma unroll
        for (int nt = 0; nt < 4; ++nt) Bf[nt] = *(const bf16x8*)(Bm + (size_t)(g * 128 + 32 * nt + r32) * 16 + 8 * hi);
#pragma unroll
        for (int ks = 0; ks < 4; ++ks) Cf[ks] = *(const bf16x8*)(Cm + (size_t)(g * 16 + l15) * 128 + 32 * ks + 8 * quad);
        float sh[8];
#pragma unroll
        for (int j = 0; j < 8; ++j) sh[j] = shift[(size_t)b * 3072 + 16 * g + 8 * hi + j];
        const float lr = lamb[(g * 64 + lane) * 2], li = lamb[(g * 64 + lane) * 2 + 1];
        const float dsk = dskip[16 * g + l15];
        float s_re = 0.f, s_im = 0.f;
        const size_t rowb = (size_t)b * SEQ;
        u32x4 hv = *(const u32x4*)(hs + (rowb + r32) * DM + 16 * g + 8 * hi);
        float rs = pg8::row_rstd(ssq, rowb + r32, 16);
        for (int tt = 0; tt < SEQ / 32; ++tt) {
            const u32x4 hc = hv; const float rc = rs;
            if (tt + 1 < SEQ / 32) { const size_t rn = rowb + 32 * (tt + 1) + r32; hv = *(const u32x4*)(hs + rn * DM + 16 * g + 8 * hi); rs = pg8::row_rstd(ssq, rn, 16); }
            float uu[8];
            uu[0] = bflo(hc.x) * rc + sh[0]; uu[1] = bfhi(hc.x) * rc + sh[1]; uu[2] = bflo(hc.y) * rc + sh[2]; uu[3] = bfhi(hc.y) * rc + sh[3];
            uu[4] = bflo(hc.z) * rc + sh[4]; uu[5] = bfhi(hc.z) * rc + sh[5]; uu[6] = bflo(hc.w) * rc + sh[6]; uu[7] = bfhi(hc.w) * rc + sh[7];
            *(LAS f32x4*)(Us + r32 * 16 + 8 * hi) = (f32x4){uu[0], uu[1], uu[2], uu[3]};
            *(LAS f32x4*)(Us + r32 * 16 + 8 * hi + 4) = (f32x4){uu[4], uu[5], uu[6], uu[7]};
            u32x4 aw; aw.x = pk2(uu[0], uu[1]); aw.y = pk2(uu[2], uu[3]); aw.z = pk2(uu[4], uu[5]); aw.w = pk2(uu[6], uu[7]);
            const bf16x8 af = __builtin_bit_cast(bf16x8, aw);
#pragma unroll
            for (int nt = 0; nt < 4; ++nt) {
                f32x16 a = {}; a = MFMA32(af, Bf[nt], a);
#pragma unroll
                for (int i = 0; i < 4; ++i) *(LAS f32x4*)(BUt + (32 * nt + r32) * 36 + 8 * i + 4 * hi) = (f32x4){a[4 * i], a[4 * i + 1], a[4 * i + 2], a[4 * i + 3]};
            }
            LDS_WAIT();
            f32x4 bre[8], bim[8];
#pragma unroll
            for (int q = 0; q < 8; ++q) { bre[q] = *(const LAS f32x4*)(BUt + lane * 36 + 4 * q); bim[q] = *(const LAS f32x4*)(BUt + (64 + lane) * 36 + 4 * q); }
#pragma unroll
            for (int q = 0; q < 8; ++q)
#pragma unroll
                for (int j = 0; j < 4; ++j) {
                    float t1, t2, nre, nim;
                    asm("v_fma_f32 %0, -%1, %2, %3" : "=v"(t1) : "v"(li), "v"(s_im), "v"(bre[q][j]));
                    asm("v_fma_f32 %0, %1, %2, %3" : "=v"(t2) : "v"(li), "v"(s_re), "v"(bim[q][j]));
                    asm("v_fma_f32 %0, %1, %2, %3" : "=v"(nre) : "v"(lr), "v"(s_re), "v"(t1));
                    asm("v_fma_f32 %0, %1, %2, %3" : "=v"(nim) : "v"(lr), "v"(s_im), "v"(t2));
                    s_re = nre; s_im = nim;
                    *(LAS unsigned*)(Ss + (4 * q + j) * 136 + 2 * lane) = pk2(s_re, s_im);
                }
            LDS_WAIT();
            f32x4 y0 = {0.f, 0.f, 0.f, 0.f}, y1 = {0.f, 0.f, 0.f, 0.f};
#pragma unroll
            for (int ks = 0; ks < 4; ++ks) {
                const bf16x8 s0 = *(const LAS bf16x8*)(Ss + l15 * 136 + 32 * ks + 8 * quad);
                const bf16x8 s1 = *(const LAS bf16x8*)(Ss + (16 + l15) * 136 + 32 * ks + 8 * quad);
                y0 = __builtin_amdgcn_mfma_f32_16x16x32_bf16(s0, Cf[ks], y0, 0, 0, 0);
                y1 = __builtin_amdgcn_mfma_f32_16x16x32_bf16(s1, Cf[ks], y1, 0, 0, 0);
            }
#pragma unroll
            for (int mt = 0; mt < 2; ++mt) {
                float zz[4];
#pragma unroll
                for (int j = 0; j < 4; ++j) { const int t = 16 * mt + 4 * quad + j; const float uval = Us[t * 16 + l15];
                    const float v = (mt == 0 ? y0[j] : y1[j]) + dsk * uval;
                    const float inner = 0.7978845608028654f * (v + 0.044715f * v * v * v);
                    const float e = __builtin_amdgcn_exp2f(-2.0f * 1.4426950408889634f * inner);
                    zz[j] = v * __builtin_amdgcn_rcpf(1.0f + e); }
                const unsigned w0 = pk2(zz[0], zz[1]), w1 = pk2(zz[2], zz[3]);
                const int t0 = 16 * mt + 4 * quad;
                Zt[(t0 + 0) * 16 + l15] = (bf16_t)(w0 & 0xffffu); Zt[(t0 + 1) * 16 + l15] = (bf16_t)(w0 >> 16);
                Zt[(t0 + 2) * 16 + l15] = (bf16_t)(w1 & 0xffffu); Zt[(t0 + 3) * 16 + l15] = (bf16_t)(w1 >> 16);
            }
            LDS_WAIT();
            { const int t = lane >> 1, hf = lane & 1; const u32x4 v = *(const LAS u32x4*)(Zt + t * 16 + hf * 8);
              *(u32x4*)(z + (rowb + 32 * tt + t) * DM + 16 * g + hf * 8) = v; }
            LDS_WAIT();
        }
    }
}

struct AttnU { int br, cc, h, bl; };
__device__ __forceinline__ AttnU attn_decode(int unit) { AttnU u; u.cc = ((unit & 7) + (unit >> 8)) & 7; u.h = (unit >> 3) & 15; u.bl = (unit >> 7) & 7; u.br = unit >> 10; return u; }
__device__ __forceinline__ void attn_wave_params(const AttnU& u, int wid, int& dil, int& q0, int& resw, int& slot0) {
    if (u.br == 0) { dil = 1; resw = 0; q0 = 256 * u.cc + 32 * wid; slot0 = 32 * wid; }
    else if (u.br == 1) { dil = 4; resw = u.cc >> 1; q0 = 256 * (u.cc & 1) + 32 * wid; slot0 = 32 * wid; }
    else { dil = 16; resw = 2 * u.cc + (wid >> 2); q0 = 32 * (wid & 3); slot0 = (wid >> 2) * 128 + q0 - 128; }
}
__device__ __forceinline__ void attn_issue_loads(const bf16_t* kv, const bf16_t* qo, const AttnU& u, int wid, int lane, u32x4 (&kreg)[6], u32x4 (&vreg)[6], bf16x8 (&qf)[4]) {
    const int tid = wid * 64 + lane, r32 = lane & 31, hi = lane >> 5;
    int kt0, smin, smax;
    if (u.br == 0) { kt0 = 256 * u.cc - 128; smin = kt0 < 0 ? 128 : 0; smax = 384; }
    else if (u.br == 1) { const int Kb = 256 * (u.cc & 1) - 128; kt0 = (u.cc >> 1) * 512 + Kb; smin = Kb < 0 ? 128 : 0; smax = 384; }
    else { kt0 = 2 * u.cc * 128; smin = 0; smax = 256; }
    const size_t tokb = (size_t)u.bl * SEQ;
    const bf16_t* kbase = kv + ((size_t)(u.br * 16 + u.h) * MH + tokb) * 64;
    const bf16_t* vbase = kv + ((size_t)((3 + u.br) * 16 + u.h) * MH + tokb) * 64;
#pragma unroll
    for (int i = 0; i < 6; ++i) {
        const int idx = tid + 512 * i, s = idx >> 3, c = idx & 7;
        const bool ok = s >= smin && s < smax;
        kreg[i] = (u32x4){0, 0, 0, 0}; vreg[i] = (u32x4){0, 0, 0, 0};
        if (ok) { kreg[i] = *(const u32x4*)(kbase + (ptrdiff_t)(kt0 + s) * 64 + 8 * c); vreg[i] = *(const u32x4*)(vbase + (ptrdiff_t)(kt0 + s) * 64 + 8 * c); }
    }
    int dl, q0, resw, slot0; attn_wave_params(u, wid, dl, q0, resw, slot0);
    const int sub = SEQ / dl;
    const bf16_t* qp = qo + ((size_t)(u.br * 16 + u.h) * MH + tokb + (size_t)resw * sub + q0 + r32) * 64;
#pragma unroll
    for (int d0 = 0; d0 < 4; ++d0) qf[d0] = *(const bf16x8*)(qp + 16 * d0 + 8 * hi);
}
__device__ __forceinline__ void attn_compute(LAS unsigned char* lds, bf16_t* qo, float* lse, const AttnU& u, const bf16x8 (&qf)[4], int wid, int lane) {
    const int r32 = lane & 31, hi = lane >> 5;
    LAS unsigned char* Kimg = lds; LAS unsigned char* Vimg = lds + 49152;
    LAS float* wsf = (LAS float*)(lds + 98304) + wid * 32;
    LAS bf16_t* stg = (LAS bf16_t*)(lds + 98304 + 1024 + wid * 4096);
    int dil, q0, resw, slot0; attn_wave_params(u, wid, dil, q0, resw, slot0);
    const int tstart = (128 - q0) > 0 ? ((128 - q0) >> 5) : 0;
    const size_t tokb = (size_t)u.bl * SEQ;
    const size_t qrow = tokb + (size_t)(q0 + r32) * dil + resw;
    const int tb = slot0 >> 5;
    f32x16 p[5];
    float mx = -1e30f;
#pragma unroll
    for (int t = 0; t < 5; ++t) {
        if (t >= tstart) {
            f32x16 a = {};
            const LAS unsigned char* kb = Kimg + ((tb + t) * 32 + r32) * 128;
#pragma unroll
            for (int d0 = 0; d0 < 4; ++d0) { const bf16x8 kf = *(const LAS bf16x8*)(kb + (((2 * d0 + hi) ^ ((r32 >> 1) & 7)) << 4)); a = MFMA32(kf, qf[d0], a); }
            if (t == 0) {
#pragma unroll
                for (int r = 0; r < 16; ++r) if (crow(r, hi) < r32) a[r] = -1e30f;
            }
            if (t == 4) {
#pragma unroll
                for (int r = 0; r < 16; ++r) if (crow(r, hi) > r32) a[r] = -1e30f;
            }
#pragma unroll
            for (int r = 0; r < 16; ++r) mx = fmaxf(mx, a[r]);
            p[t] = a;
        } else {
#pragma unroll
            for (int r = 0; r < 16; ++r) p[t][r] = -1e30f;
        }
    }
    mx = fmaxf(mx, __shfl_xor(mx, 32));
    float lsum = 0.f;
#pragma unroll
    for (int t = 0; t < 5; ++t)
#pragma unroll
        for (int r = 0; r < 16; ++r) { const float e = __builtin_amdgcn_exp2f(p[t][r] - mx); p[t][r] = e; lsum += e; }
    lsum += __shfl_xor(lsum, 32);
    f32x16 o[2]; o[0] = (f32x16){}; o[1] = (f32x16){};
    const int vlane = ((lane >> 4) & 1) * 32 + (lane & 3) * 8 + (4 * hi + ((lane & 15) >> 2)) * 64;
#pragma unroll
    for (int t = 0; t < 5; ++t) {
        if (t >= tstart) {
            const int sb = slot0 + 32 * t;
#pragma unroll
            for (int ks = 0; ks < 2; ++ks) {
                u32x4 pw; pw.x = pk2(p[t][8 * ks + 0], p[t][8 * ks + 1]); pw.y = pk2(p[t][8 * ks + 2], p[t][8 * ks + 3]); pw.z = pk2(p[t][8 * ks + 4], p[t][8 * ks + 5]); pw.w = pk2(p[t][8 * ks + 6], p[t][8 * ks + 7]);
                const bf16x8 pa = __builtin_bit_cast(bf16x8, pw);
#pragma unroll
                for (int dh = 0; dh < 2; ++dh) {
                    const LAS unsigned char* vp = Vimg + dh * 24576 + (sb + 16 * ks) * 64 + vlane;
                    const s16x4 lo = __builtin_bit_cast(s16x4, __builtin_amdgcn_ds_read_tr16_b64_v4i16((LAS s16x4*)vp));
                    const s16x4 hh = __builtin_bit_cast(s16x4, __builtin_amdgcn_ds_read_tr16_b64_v4i16((LAS s16x4*)(vp + 512)));
                    const bf16x8 vf = (bf16x8){lo[0], lo[1], lo[2], lo[3], hh[0], hh[1], hh[2], hh[3]};
                    o[dh] = MFMA32(pa, vf, o[dh]);
                }
            }
        }
    }
    const float linv = 1.0f / lsum;
    if (hi == 0) { wsf[r32] = linv; lse[qrow * 48 + u.br * 16 + u.h] = (mx + __builtin_amdgcn_logf(lsum)) * 0.6931471805599453f; }
    LDS_WAIT();
#pragma unroll
    for (int r = 0; r < 16; ++r) { const int orow = crow(r, hi); const float li_ = wsf[orow];
#pragma unroll
        for (int dh = 0; dh < 2; ++dh) stg[orow * 64 + dh * 32 + r32] = (bf16_t)f2bf(o[dh][r] * li_); }
    LDS_WAIT();
#pragma unroll
    for (int i = 0; i < 4; ++i) { const int row = i * 8 + (lane >> 3), ch = lane & 7; const u32x4 v = *(const LAS u32x4*)(stg + row * 64 + ch * 8);
        *(u32x4*)(qo + ((size_t)(u.br * 16 + u.h) * MH + tokb + (size_t)resw * (SEQ / dil) + q0 + row) * 64 + ch * 8) = v; }
    LDS_WAIT();
}
__device__ __forceinline__ void attn_phase(LAS unsigned char* lds, bf16_t* qo, const bf16_t* kv, float* lse, const int wid) {
    const int G = (int)gridDim.x, bx = (int)blockIdx.x; const int vcu = (G % 8 == 0) ? (bx % 8) * (G / 8) + bx / 8 : bx;
    qo = opq(qo); kv = opq(kv); lse = opq(lse);
    constexpr int NUNITS = 3 * 8 * 16 * 8;
    LAS unsigned char* Kimg = lds; LAS unsigned char* Vimg = lds + 49152;
    u32x4 kreg[6], vreg[6]; bf16x8 qn[4];
    int unit = vcu;
    if (unit < NUNITS) { const AttnU u0 = attn_decode(unit); attn_issue_loads(kv, qo, u0, wid, lane_id(), kreg, vreg, qn); }
    for (; unit < NUNITS; unit += G) {
        int lane = lane_id();
        const AttnU u = attn_decode(unit);
        { const int tid = wid * 64 + lane;
#pragma unroll
          for (int i = 0; i < 6; ++i) {
            const int idx = tid + 512 * i, s = idx >> 3, c = idx & 7;
            *(LAS u32x4*)(Kimg + s * 128 + ((c ^ ((s >> 1) & 7)) << 4)) = kreg[i];
            *(LAS u32x4*)(Vimg + (c >> 2) * 24576 + s * 64 + (c & 3) * 16) = vreg[i];
          } }
        bf16x8 qc[4];
#pragma unroll
        for (int d0 = 0; d0 < 4; ++d0) qc[d0] = qn[d0];
        __syncthreads();
        if (unit + G < NUNITS) { const AttnU un = attn_decode(unit + G); attn_issue_loads(kv, qo, un, wid, lane, kreg, vreg, qn); }
        attn_compute(lds, qo, lse, u, qc, wid, lane);
        __syncthreads();
    }
}

#define XB_TMO      128
#define XB_XCNT(j)  (256  + 64 * (j))
#define XB_XSUB(j)  (1280 + 64 * (j))
#define XB_XGEN(j)  (2304 + 64 * (j))
#define XB_TOP      3328
#define XB_TOPGEN   3392
#define XCD_BAR_WORDS 3456
#define XB_SPIN_CAP (1u << 20)
__device__ __forceinline__ unsigned xb_ld(unsigned* p)              { return __hip_atomic_load(p, __ATOMIC_RELAXED, __HIP_MEMORY_SCOPE_AGENT); }
__device__ __forceinline__ unsigned xb_add(unsigned* p, unsigned v) { return __hip_atomic_fetch_add(p, v, __ATOMIC_RELAXED, __HIP_MEMORY_SCOPE_AGENT); }
__device__ __forceinline__ unsigned xb_xcc_id() { return (unsigned)__builtin_amdgcn_s_getreg((3 << 11) | 20) & 0xFu; }
#define XB_SPIN(cond, bar) do { unsigned _sp = 0; while (cond) { __builtin_amdgcn_s_sleep(1); \
    if ((++_sp & 255u) == 0u) { if (xb_ld(&(bar)[XB_TMO])) break; if (_sp > XB_SPIN_CAP) { atomicAdd(&(bar)[XB_TMO], 1u); break; } } } } while (0)
struct XcdBarrier { unsigned* bar; unsigned x; volatile LAS unsigned* st; };
__device__ __forceinline__ void xcd_barrier_complete(unsigned* bar, unsigned x, unsigned& nloc, unsigned& nx) {
    const unsigned G = gridDim.x;
    unsigned sum, cnt, mine, sp = 0u;
    for (;;) {
        sum = 0u; cnt = 0u; mine = 0u;
#pragma unroll
        for (unsigned j = 0; j < 16; ++j) { const unsigned c = xb_ld(&bar[XB_XCNT(j)]); sum += c; cnt += (c > 0u) ? 1u : 0u; mine = (j == x) ? c : mine; }
        if (sum == G) break;
        __builtin_amdgcn_s_sleep(1);
        if ((++sp & 255u) == 0u) { if (xb_ld(&bar[XB_TMO])) break; if (sp > XB_SPIN_CAP) { atomicAdd(&bar[XB_TMO], 1u); break; } }
    }
    nloc = mine > 0u ? mine : 1u; nx = cnt > 0u ? cnt : 1u;
}
__device__ __forceinline__ void xcd_barrier(const XcdBarrier& b, const bool leader) {
    asm volatile("s_waitcnt vmcnt(0)" ::: "memory");
    __syncthreads();
    if (leader) {
        unsigned* bar = b.bar;
        __builtin_amdgcn_s_waitcnt(0);
        unsigned nloc = b.st[0], nx = b.st[1];
        if (nloc == 0u) { xcd_barrier_complete(bar, b.x, nloc, nx); b.st[0] = nloc; b.st[1] = nx; }
        const unsigned old = xb_add(&bar[XB_XSUB(b.x)], 1u);
        const unsigned gen = old / nloc;
        if (old + 1u == (gen + 1u) * nloc) {
            __builtin_amdgcn_fence(__ATOMIC_RELEASE, "agent");
            asm volatile("s_waitcnt vmcnt(0)" ::: "memory");
            const unsigned og = xb_add(&bar[XB_TOP], 1u);
            const unsigned tg = og / nx;
            if (og + 1u == (tg + 1u) * nx) xb_add(&bar[XB_TOPGEN], 1u);
            else XB_SPIN(xb_ld(&bar[XB_TOPGEN]) == tg, bar);
            __builtin_amdgcn_fence(__ATOMIC_ACQUIRE, "agent");
            xb_add(&bar[XB_XGEN(b.x)], 1u);
            asm volatile("s_waitcnt vmcnt(0)" ::: "memory");
        } else {
            XB_SPIN(xb_ld(&bar[XB_XGEN(b.x)]) == gen, bar);
            __builtin_amdgcn_fence(__ATOMIC_ACQUIRE, "agent");
            asm volatile("s_waitcnt vmcnt(0)" ::: "memory");
        }
    }
    __syncthreads();
}

struct Args { const float* in[23]; float* out; unsigned char* ws; int ph_lo, ph_hi; };

__global__ void __launch_bounds__(512, 2) fwd(Args a) {
    extern __shared__ __attribute__((aligned(16))) unsigned char lds_raw[];
    LAS unsigned char* lds = (LAS unsigned char*)lds_raw;
    const int wid = __builtin_amdgcn_readfirstlane((int)threadIdx.x >> 6);
    if (a.ph_lo < 0) cg::this_grid().sync();
    const int G = (int)gridDim.x, bx = (int)blockIdx.x;
    volatile LAS unsigned* bst = (volatile LAS unsigned*)(lds + LDS_BYTES - 64);
    XcdBarrier bar; bar.bar = (unsigned*)a.ws; bar.x = xb_xcc_id(); bar.st = bst;
    { const int tid0 = wid * 64 + lane_id();
      if (tid0 < 16) bst[tid0] = 0u;
      __syncthreads();
      if (a.ph_hi - a.ph_lo > 1) { if (tid0 == 0) (void)xb_add(&bar.bar[XB_XCNT(bar.x)], 1u); } }
    const int gw = bx * 8 + wid, NGW = G * 8;
    unsigned char* ws = a.ws;
    const float* x = a.in[0]; const float* cvec = a.in[1]; const float* ln_g = a.in[2]; const float* ada_w = a.in[3]; const float* ada_b = a.in[4];
    const float* lam_re = a.in[5]; const float* lam_im = a.in[6]; const float* log_dt = a.in[7]; const float* b_re = a.in[8]; const float* b_im = a.in[9];
    const float* c_re = a.in[10]; const float* c_im = a.in[11]; const float* ssm_d = a.in[12]; const float* w_glu = a.in[13]; const float* kv_g = a.in[14];
    const float* kv_ada_w = a.in[15]; const float* kv_ada_b = a.in[16]; const float* w_kv = a.in[17]; const float* w_q = a.in[18]; const float* w_o = a.in[19];
    const float* w1 = a.in[20]; const float* w2 = a.in[21]; const float* final_g = a.in[22];
    bf16_t* hbuf = (bf16_t*)a.out;
    float* mods = (float*)(ws + WS_MODS); float* kvmods = (float*)(ws + WS_KVMODS); float* GM = (float*)(ws + WS_GM);
    float* sw1 = (float*)(ws + WS_SW1); float* swq = (float*)(ws + WS_SWQ); float* swkv = (float*)(ws + WS_SWKV);
    float* lamb = (float*)(ws + WS_LAMB); bf16_t* Bm = (bf16_t*)(ws + WS_BM); bf16_t* Cm = (bf16_t*)(ws + WS_CM);
    float* lse = (float*)(ws + WS_LSE); float* ssq = (float*)(ws + WS_SSQ);
    bf16_t* wkv_t = (bf16_t*)(ws + WS_WKV); bf16_t* wq_t = (bf16_t*)(ws + WS_WQ); bf16_t* wo_t = (bf16_t*)(ws + WS_WO);
    bf16_t* wglu_t = (bf16_t*)(ws + WS_WGLU);
    bf16_t* hs = (bf16_t*)(ws + WS_HS); bf16_t* hskv0 = (bf16_t*)(ws + WS_HSKV0); bf16_t* hskv1 = (bf16_t*)(ws + WS_HSKV1);
    bf16_t* qbuf = (bf16_t*)(ws + WS_Q); bf16_t* obuf = (bf16_t*)(ws + WS_O); bf16_t* acth = (bf16_t*)(ws + WS_ACTH); bf16_t* kvh = (bf16_t*)(ws + WS_KVH);
    bf16_t* zbuf = (bf16_t*)(ws + WS_Z); bf16_t* actf = (bf16_t*)(ws + WS_ACTF);
#define W1T(l) ((bf16_t*)(ws + ((l) < 2 ? WS_W1A + (size_t)(l) * 8 * MiB : WS_W1B + (size_t)((l) - 2) * 8 * MiB)))
#define W2T(l) ((bf16_t*)(ws + ((l) < 2 ? WS_W2A + (size_t)(l) * 8 * MiB : WS_W2B + (size_t)((l) - 2) * 8 * MiB)))
#define MODS(l, j) (mods + (size_t)((l) * 2 + (j)) * 16 * 3072)
#define GMT(idx) (GM + (size_t)(idx) * 16 * DM)

    int ph = 0; const int lo = a.ph_lo, hi_ = a.ph_hi;
#ifndef PROBE_DUP
#define PROBE_DUP 0
#endif
#define PH_BEGIN if (ph >= lo && ph < hi_) {
#define PH_BEGIN_G(g) if (ph >= lo && ph < hi_) for (int rep_ = 0; rep_ <= ((PROBE_DUP >> (g)) & 1); ++rep_) {
#define PH_END } ++ph; if (ph > lo && ph < hi_) xcd_barrier(bar, wid == 0 && lane_id() == 0);

    PH_BEGIN_G(0)
    {
        const int lane = lane_id(), tid = wid * 64 + lane;
        LAS float* scr = (LAS float*)(lds + wid * 8448);
        for (int it = gw; it < 16 * 64; it += NGW) transpose_item(w_glu, 1024, 2048, wglu_t, 1, scr, it, lane);
        for (int i = bx * 512 + tid; i < 2 * 64 * 64; i += G * 512) {
            const int p = i & 63, g = (i >> 6) & 63, l = i >> 12;
            const double dt = exp_d((double)log_dt[l * 64 + g]);
            const double lre = (double)lam_re[i], lim = (double)lam_im[i];
            const double ea = exp_d(lre * dt); double sn, cs; sincos_d(lim * dt, sn, cs);
            const double are = ea * cs, aim = ea * sn;
            lamb[i * 2] = (float)are; lamb[i * 2 + 1] = (float)aim;
            const double nre = are - 1.0, nim = aim, den = lre * lre + lim * lim;
            const double fre = (nre * lre + nim * lim) / den, fim = (nim * lre - nre * lim) / den;
            const size_t lg = (size_t)(l * 64 + g);
            for (int c = 0; c < 16; ++c) {
                const double br_ = (double)b_re[(size_t)i * 16 + c], bi_ = (double)b_im[(size_t)i * 16 + c];
                Bm[(lg * 128 + p) * 16 + c] = (bf16_t)f2bf((float)(fre * br_ - fim * bi_));
                Bm[(lg * 128 + 64 + p) * 16 + c] = (bf16_t)f2bf((float)(fre * bi_ + fim * br_));
                Cm[(lg * 16 + c) * 128 + 2 * p] = (bf16_t)f2bf(c_re[(lg * 16 + c) * 64 + p]);
                Cm[(lg * 16 + c) * 128 + 2 * p + 1] = (bf16_t)f2bf(-c_im[(lg * 16 + c) * 64 + p]);
            }
        }
        LAS float* vs = (LAS float*)lds; LAS float* red = (LAS float*)(lds + 65536);
        gemv_load_vec(vs, cvec, 1024, true, wid);
        for (int it = bx; it < 8 * 48 + 32; it += G) {
            if (it < 8 * 48) { const int mi = it / 48, cgp = it % 48; gemv_item(vs, red, ada_w + (size_t)mi * 1024 * 3072, 3072, ada_b + (size_t)mi * 3072, mods + (size_t)mi * 16 * 3072, cgp * 64, wid); }
            else { const int cgp = it - 8 * 48; gemv_item(vs, red, kv_ada_w, 2048, kv_ada_b, kvmods, cgp * 64, wid); }
        }
    }
    PH_END

    PH_BEGIN_G(1)
    {
        const int lane = lane_id(), tid = wid * 64 + lane;
        for (int i = bx * 512 + tid; i < 9 * 16 * DM; i += G * 512) {
            const int k = i & 1023, b = (i >> 10) & 15, idx = i >> 14;
            float gv, sc;
            if (idx < 8) { gv = ln_g[idx * DM + k]; sc = mods[((size_t)idx * 16 + b) * 3072 + 1024 + k]; } else { gv = kv_g[k]; sc = kvmods[(size_t)b * 2048 + 1024 + k]; }
            GM[i] = gv * (1.0f + sc);
        }
        LAS float* vs = (LAS float*)lds; LAS float* red = (LAS float*)(lds + 65536);
        for (int it = bx; it < 448; it += G) {
            if (it < 256) { const int l = it >> 6, cgp = it & 63; gemv_load_vec(vs, MODS(l, 1), 3072, false, wid); gemv_item(vs, red, w1 + (size_t)l * 1024 * FF, FF, nullptr, sw1 + (size_t)l * 16 * FF, cgp * 64, wid); }
            else if (it < 352) { const int j = (it - 256) / 48, cgp = (it - 256) % 48; gemv_load_vec(vs, MODS(2 + j, 0), 3072, false, wid); gemv_item(vs, red, w_q + (size_t)j * 1024 * QW, QW, nullptr, swq + (size_t)j * 16 * QW, cgp * 64, wid); }
            else { const int cgp = it - 352; gemv_load_vec(vs, kvmods, 2048, false, wid); gemv_item(vs, red, w_kv, KVW, nullptr, swkv, cgp * 64, wid); }
        }
        for (int m = gw; m < MTOK; m += NGW) {
            const int b = m >> 11; const f32x4* xr = (const f32x4*)(x + (size_t)m * DM) + lane;
            f32x4 v[4]; float s = 0.f;
#pragma unroll
            for (int j = 0; j < 4; ++j) { v[j] = xr[64 * j]; s += (v[j][0] * v[j][0] + v[j][1] * v[j][1]) + (v[j][2] * v[j][2] + v[j][3] * v[j][3]); }
            s = wave_sum(s);
            if (lane < 16) ssq[(size_t)m * SSQ_LD + lane] = lane == 0 ? s : 0.f;
#pragma unroll
            for (int j = 0; j < 4; ++j) { const int k = 4 * lane + 256 * j;
                const f32x4 gv = *(const f32x4*)(ln_g + k); const f32x4 sc = *(const f32x4*)(mods + (size_t)b * 3072 + 1024 + k);
                const f32x4 hv = v[j] * (gv * (1.0f + sc)); u32x2 w; w.x = pk2(hv[0], hv[1]); w.y = pk2(hv[2], hv[3]);
                *(u32x2*)(hs + (size_t)m * DM + k) = w; }
        }
    }
    PH_END

    for (int l = 0; l < 2; ++l) {
        PH_BEGIN_G(2)
#ifndef NO_S5
        if (wid >= 4) {
            const int lane = lane_id();
            LAS float* scr = (LAS float*)(lds + 4 * 30208 + (wid - 4) * 8448);
            const int gw4 = bx * 4 + (wid - 4), NGW4 = G * 4;
            constexpr int I_GLU = 16 * 64, I_KV = 16 * 192, I_Q = 16 * 96, I_O = 16 * 32, I_1 = 16 * 128, I_2 = 64 * 32;
            constexpr int NITEMS = I_GLU + I_KV + 2 * I_Q + 2 * I_O + 4 * I_1 + 4 * I_2;
            const int nset = l == 0 ? 9216 : NITEMS - 9216;
            for (int k = gw4; k < nset; k += NGW4) {
                int r;
                if (l == 0) r = k < 4096 ? k : (k < 8192 ? 8192 + (k - 4096) : 16384 + (k - 8192));
                else        r = k < 4096 ? 4096 + k : (k < 8192 ? 12288 + (k - 4096) : 17408 + (k - 8192));
                if (r < 4 * I_1) { const int li = r / I_1; transpose_item(w1 + (size_t)li * 1024 * FF, 1024, FF, W1T(li), 0, scr, r % I_1, lane); continue; } r -= 4 * I_1;
                if (r < 4 * I_2) { const int li = r / I_2; transpose_item(w2 + (size_t)li * FF * 1024, FF, 1024, W2T(li), 0, scr, r % I_2, lane); continue; } r -= 4 * I_2;
                if (r < I_GLU) { transpose_item(w_glu + (size_t)1024 * 2048, 1024, 2048, wglu_t + (size_t)2048 * 1024, 1, scr, r, lane); continue; } r -= I_GLU;
                if (r < I_KV) { transpose_item(w_kv, 1024, KVW, wkv_t, 0, scr, r, lane); continue; } r -= I_KV;
                if (r < 2 * I_Q) { const int li = r / I_Q; transpose_item(w_q + (size_t)li * 1024 * QW, 1024, QW, wq_t + (size_t)li * QW * 1024, 0, scr, r % I_Q, lane); continue; } r -= 2 * I_Q;
                { const int li = r / I_O; transpose_item(w_o + (size_t)li * 1024 * 1024, 1024, 1024, wo_t + (size_t)li * 1024 * 1024, 0, scr, r % I_O, lane); }
            }
        }
        s5_phase(lds, hs, ssq, MODS(l, 0), lamb + (size_t)l * 64 * 64 * 2, Bm + (size_t)l * 64 * 128 * 16, Cm + (size_t)l * 64 * 16 * 128, ssm_d + (size_t)l * DM, zbuf, wid);
#endif
        PH_END
        PH_BEGIN
        { pg8::EpiGlu E{l == 0 ? (const void*)x : (const void*)hbuf, l == 0 ? 1 : 0, hbuf, hs, MODS(l, 0) + 2048, GMT(l * 2 + 1), ssq, 0};
          run_gemm(lds, zbuf, wglu_t + (size_t)l * 2048 * 1024, MTOK, 2048, 1024, E, wid); }
        PH_END
        PH_BEGIN_G(3)
        { rstd_to_lds(lds, ssq, 32, 0, MTOK, FF, wid);
          pg8::EpiActT<1, false, false> E{actf, FF, ssq, 32, sw1 + (size_t)l * 16 * FF, 0, 1.0f, (unsigned)(unsigned long)(lds + RL_OFF)};
          run_gemm(lds, hs, W1T(l), MTOK, FF, 1024, E, wid); }
        PH_END
        PH_BEGIN
        { pg8::EpiRes E{hbuf, hbuf, hs, MODS(l, 1) + 2048, GMT(l * 2 + 2), ssq, 0, hskv0, hskv1, l == 1 ? GMT(8) : nullptr};
          run_gemm(lds, actf, W2T(l), MTOK, 1024, FF, E, wid); }
        PH_END
    }

    for (int hb = 0; hb < 2; ++hb) {
        const int ro = hb * MH;
        const bf16_t* hskv = hb == 0 ? hskv0 : hskv1;
        for (int l = 2; l < 4; ++l) {
            const int j = l - 2;
            PH_BEGIN_G(4)
            if (l == 2) { rstd_to_lds(lds, ssq, 16, ro, MH, KVW, wid);
                pg8::EpiActT<0, false, true> E{kvh, KVW, ssq, 16, swkv, ro, 1.0f, (unsigned)(unsigned long)(lds + RL_OFF)}; run_gemm(lds, hskv, wkv_t, MH, KVW, 1024, E, wid); }
            { rstd_to_lds(lds, ssq, 16, ro, MH, QW, wid);
              pg8::EpiActT<0, true, true> E{qbuf, QW, ssq, 16, swq + (size_t)j * 16 * QW, ro, C2, (unsigned)(unsigned long)(lds + RL_OFF)}; run_gemm(lds, hs + (size_t)ro * DM, wq_t + (size_t)j * QW * 1024, MH, QW, 1024, E, wid); }
            PH_END
            PH_BEGIN
#ifndef NO_ATTN
            attn_phase(lds, qbuf, kvh, lse, wid);
            if ((PROBE_DUP >> 7) & 1) {
                xcd_barrier(bar, wid == 0 && lane_id() == 0);
                { pg8::EpiActT<0, true, true> E{qbuf, QW, ssq, 16, swq + (size_t)j * 16 * QW, ro, C2, (unsigned)(unsigned long)(lds + RL_OFF)}; run_gemm(lds, hs + (size_t)ro * DM, wq_t + (size_t)j * QW * 1024, MH, QW, 1024, E, wid); }
                xcd_barrier(bar, wid == 0 && lane_id() == 0);
                attn_phase(lds, qbuf, kvh, lse, wid);
            }
            if ((PROBE_DUP >> 8) & 1) { for (int rb = 0; rb < 10; ++rb) xcd_barrier(bar, wid == 0 && lane_id() == 0); }
#endif
            PH_END
            PH_BEGIN_G(5)
            const int lane = lane_id();
            for (int m = gw; m < MH; m += NGW) {
                const int h = lane >> 2; const float* lp = lse + (size_t)m * 48 + h;
                const float l0 = lp[0], l1 = lp[16], l2 = lp[32]; const float mm = fmaxf(l0, fmaxf(l1, l2));
                float e0 = __expf(l0 - mm), e1 = __expf(l1 - mm), e2 = __expf(l2 - mm); const float inv = 1.0f / (e0 + e1 + e2); e0 *= inv; e1 *= inv; e2 *= inv;
                const int mb = m & ~2047, pos = m & 2047, dd = (lane & 3) * 16;
                const bf16_t* q0p = qbuf + ((size_t)(0 * 16 + h) * MH + mb + pos) * 64 + dd;
                const bf16_t* q1p = qbuf + ((size_t)(1 * 16 + h) * MH + mb + pg8::perm_pos(1, pos)) * 64 + dd;
                const bf16_t* q2p = qbuf + ((size_t)(2 * 16 + h) * MH + mb + pg8::perm_pos(2, pos)) * 64 + dd;
#pragma unroll
                for (int c = 0; c < 2; ++c) { const u32x4 a0 = *(const u32x4*)(q0p + 8 * c), a1 = *(const u32x4*)(q1p + 8 * c), a2 = *(const u32x4*)(q2p + 8 * c);
                    u32x4 w;
#pragma unroll
                    for (int q = 0; q < 4; ++q) { const float lo_ = e0 * bflo(a0[q]) + e1 * bflo(a1[q]) + e2 * bflo(a2[q]); const float hi2 = e0 * bfhi(a0[q]) + e1 * bfhi(a1[q]) + e2 * bfhi(a2[q]); w[q] = pk2(lo_, hi2); }
                    *(u32x4*)(obuf + (size_t)m * DM + 16 * lane + 8 * c) = w; }
            }
            PH_END
            PH_BEGIN
            { pg8::EpiRes E{hbuf, hbuf, hs, MODS(l, 0) + 2048, GMT(l * 2 + 1), ssq, ro, nullptr, nullptr, nullptr};
              run_gemm(lds, obuf, wo_t + (size_t)j * 1024 * 1024, MH, 1024, 1024, E, wid); }
            PH_END
            PH_BEGIN_G(3)
            { rstd_to_lds(lds, ssq, 16, ro, MH, FF, wid);
              pg8::EpiActT<1, false, false> E{acth, FF, ssq, 16, sw1 + (size_t)l * 16 * FF, ro, 1.0f, (unsigned)(unsigned long)(lds + RL_OFF)};
              run_gemm(lds, hs + (size_t)ro * DM, W1T(l), MH, FF, 1024, E, wid); }
            PH_END
            PH_BEGIN
            if (l == 2) { pg8::EpiRes E{hbuf, hbuf, hs, MODS(l, 1) + 2048, GMT(l * 2 + 2), ssq, ro, nullptr, nullptr, nullptr};
              run_gemm(lds, acth, W2T(l), MH, 1024, FF, E, wid); }
            else { pg8::EpiFinal E{hbuf, a.out, MODS(l, 1) + 2048, final_g, (float*)(ws + 512 * 1024), (unsigned*)(ws + 32768), ro, (unsigned)(unsigned long)(lds + RL_OFF)};
              run_gemm(lds, acth, W2T(l), MH, 1024, FF, E, wid); }
            PH_END
        }
    }

}
constexpr int NPHASES = 2 + 8 + 2 * (2 * 6);

extern "C" void kernel_launch(void* const* d_in, const int* in_sizes, int n_in, void* d_out, int out_size, void* d_ws, size_t ws_size, hipStream_t stream) {
    static int grid = 0;
    if (grid == 0) {
        if (n_in != 23 || out_size != MTOK * DM || ws_size < WS_NEED) { fprintf(stderr, "kernel_launch: unexpected shapes (n_in %d out %d ws %zu)\n", n_in, out_size, ws_size); grid = -1; return; }
        int dev = 0, cus = 0, per_cu = 0;
        hipGetDevice(&dev); hipDeviceGetAttribute(&cus, hipDeviceAttributeMultiprocessorCount, dev);
        hipFuncSetAttribute((const void*)fwd, hipFuncAttributeMaxDynamicSharedMemorySize, LDS_BYTES);
        hipOccupancyMaxActiveBlocksPerMultiprocessor(&per_cu, (const void*)fwd, 512, LDS_BYTES);
        (void)hipGetLastError();
        if (per_cu < 1) per_cu = 1;
        if (cus < 256) { fprintf(stderr, "kernel_launch: built for a 256-CU device (phase tilings assume 256 co-resident workgroups); found %d CUs\n", cus); grid = -1; return; }
        grid = 256;
    }
    if (grid < 0) return;
    (void)hipMemsetAsync(d_ws, 0, 65536, stream);
    Args a{};
    for (int i = 0; i < 23; ++i) a.in[i] = (const float*)d_in[i];
    a.out = (float*)d_out; a.ws = (unsigned char*)d_ws;
#if ONE_LAUNCH
    a.ph_lo = 0; a.ph_hi = NPHASES;
    void* args[] = {&a};
    hipError_t e = hipLaunchCooperativeKernel((const void*)fwd, dim3(grid), dim3(512), args, LDS_BYTES, stream);
    if (e != hipSuccess) fprintf(stderr, "cooperative launch failed: %s (grid %d)\n", hipGetErrorString(e), grid);
#else
    for (int p = 0; p < NPHASES; ++p) {
        a.ph_lo = p; a.ph_hi = p + 1;
        hipLaunchKernelGGL(fwd, dim3(grid), dim3(512), LDS_BYTES, stream, a);
    }
#endif
}
```
